# Optimizing an MI355X kernel written in HIP

```python
import math
import jax, jax.numpy as jnp
from jax import lax
import numpy as np

D_MODEL = 2048
BATCH = 16
SEQ = 2048
DEPTH = 1
DEC_BATCH = 128
DEC_SEQ = 1
PAST_LEN = 16384
PAGE_SIZE = 128

SWA_HEADS = 16
SWA_KV_HEADS = 4
SWA_GROUP = SWA_HEADS // SWA_KV_HEADS
SWA_HEAD_DIM = 64
WINDOW = 128
SWA_BLOCK = 128
SWA_Q_DIM = SWA_HEADS * SWA_HEAD_DIM
SWA_KV_DIM = SWA_KV_HEADS * SWA_HEAD_DIM

SSD_D_INNER = D_MODEL
SSD_HEAD_DIM = 64
SSD_HEADS = SSD_D_INNER // SSD_HEAD_DIM
SSD_GROUPS = 4
SSD_HPG = SSD_HEADS // SSD_GROUPS
SSD_D_STATE = 128
SSD_CONV = 4
SSD_CHUNK = 128
SSD_CONV_CH = SSD_D_INNER + 2 * SSD_GROUPS * SSD_D_STATE

MEM_TOKENS = 256
MEM_HEADS = 4
MEM_HEAD_DIM = 256
MEM_DIM = MEM_HEADS * MEM_HEAD_DIM

N_BRANCH = 3
D_FF = ((8 * D_MODEL + 3 * 256 - 1) // (3 * 256)) * 256
EPS = 1e-6

IN_SPLITS = (SWA_Q_DIM, SWA_KV_DIM, SWA_KV_DIM, SSD_D_INNER, SSD_CONV_CH, SSD_HEADS, MEM_DIM, N_BRANCH * D_MODEL)
IN_DIM = sum(IN_SPLITS)

kernel_name = "hybrid_swa_ssd_memxattn_decoder_step"


def _split_points(sizes):
    pts, acc = [], 0
    for s in sizes[:-1]:
        acc += s
        pts.append(acc)
    return pts


def _rmsnorm(x, g):
    xf = x.astype(jnp.float32)
    y = xf * lax.rsqrt(jnp.mean(jnp.square(xf), axis=-1, keepdims=True) + EPS)
    return (y * g.astype(jnp.float32)).astype(x.dtype)


def _alibi_slopes():
    h = jnp.arange(1, SWA_HEADS + 1, dtype=jnp.float32)
    return jnp.exp2(-8.0 * h / SWA_HEADS).reshape(SWA_KV_HEADS, SWA_GROUP)


def _in_proj(x, norm_mix, w_in, q_norm_swa, k_norm_swa, q_norm_mem):
    b, t, _ = x.shape
    h = _rmsnorm(x, norm_mix)
    q, k, v, z, xbc, dt, qm, g = jnp.split(h @ w_in, _split_points(IN_SPLITS), axis=-1)
    q = _rmsnorm(q.reshape(b, t, SWA_KV_HEADS, SWA_GROUP, SWA_HEAD_DIM), q_norm_swa)
    k = _rmsnorm(k.reshape(b, t, SWA_KV_HEADS, SWA_HEAD_DIM), k_norm_swa)
    v = v.reshape(b, t, SWA_KV_HEADS, SWA_HEAD_DIM)
    qm = _rmsnorm(qm.reshape(b, t, MEM_HEADS, MEM_HEAD_DIM), q_norm_mem)
    gates = jax.nn.sigmoid(g.astype(jnp.float32)).astype(x.dtype).reshape(b, t, N_BRANCH, D_MODEL)
    return q, k, v, z, xbc, dt, qm, gates


def _swa_attend(q, k, v, q_pos, k_pos, sinks):
    f32 = jnp.float32
    s = jnp.einsum('...qhgd,...khd->...hgqk', q, k).astype(f32) * (SWA_HEAD_DIM ** -0.5)
    dist = q_pos[..., :, None] - k_pos[..., None, :]
    allowed = (dist >= 0) & (dist <= WINDOW) & (k_pos[..., None, :] >= 0)
    dist = dist[..., None, None, :, :].astype(f32)
    allowed = allowed[..., None, None, :, :]
    s = jnp.where(allowed, s - _alibi_slopes()[:, :, None, None] * dist, -jnp.inf)
    sink = sinks.astype(f32).reshape(SWA_KV_HEADS, SWA_GROUP)[:, :, None]
    m = jnp.maximum(jnp.max(s, axis=-1), sink)
    p = jnp.exp(s - m[..., None])
    denom = jnp.sum(p, axis=-1) + jnp.exp(sink - m)
    p = p / denom[..., None]
    o = jnp.einsum('...hgqk,...khd->...qhgd', p, v.astype(f32))
    return o.astype(q.dtype)


def _swa_prompt(q, k, v, sinks):
    b, t = q.shape[:2]
    nb = t // SWA_BLOCK
    qb = q.reshape(b, nb, SWA_BLOCK, SWA_KV_HEADS, SWA_GROUP, SWA_HEAD_DIM)
    kb = k.reshape(b, nb, SWA_BLOCK, SWA_KV_HEADS, SWA_HEAD_DIM)
    vb = v.reshape(b, nb, SWA_BLOCK, SWA_KV_HEADS, SWA_HEAD_DIM)
    pad = ((0, 0), (1, 0), (0, 0), (0, 0), (0, 0))
    kcat = jnp.concatenate([jnp.pad(kb, pad)[:, :-1], kb], axis=2)
    vcat = jnp.concatenate([jnp.pad(vb, pad)[:, :-1], vb], axis=2)
    pos = jnp.arange(t, dtype=jnp.int32).reshape(nb, SWA_BLOCK)
    kpos = jnp.concatenate([pos - SWA_BLOCK, pos], axis=-1)
    o = _swa_attend(qb, kcat, vcat, pos, kpos, sinks)
    return o.reshape(b, t, SWA_Q_DIM)


def _ssd(xbc_raw, z, dt_raw, conv_buf, h0, conv_w, conv_b, dt_bias, a_log, d_skip, ssd_norm):
    f32 = jnp.float32
    b, L, _ = xbc_raw.shape
    xpad = jnp.concatenate([conv_buf.astype(f32), xbc_raw.astype(f32)], axis=1)
    conv = lax.conv_general_dilated(xpad, conv_w.astype(f32)[:, None, :], (1,), 'VALID',
                                    dimension_numbers=('NWC', 'WIO', 'NWC'),
                                    feature_group_count=SSD_CONV_CH)
    xbc = jax.nn.silu(conv + conv_b.astype(f32))
    new_conv = xpad[:, L:]
    xs, bm, cm = jnp.split(xbc, [SSD_D_INNER, SSD_D_INNER + SSD_GROUPS * SSD_D_STATE], axis=-1)
    l = SSD_CHUNK if L % SSD_CHUNK == 0 else L
    c = L // l
    x = xs.reshape(b, c, l, SSD_GROUPS, SSD_HPG, SSD_HEAD_DIM)
    bm = bm.reshape(b, c, l, SSD_GROUPS, SSD_D_STATE)
    cm = cm.reshape(b, c, l, SSD_GROUPS, SSD_D_STATE)
    dt = jax.nn.softplus(dt_raw.astype(f32) + dt_bias.astype(f32)).reshape(b, c, l, SSD_GROUPS, SSD_HPG)
    a = -jnp.exp(a_log.astype(f32)).reshape(SSD_GROUPS, SSD_HPG)
    acs = jnp.cumsum(dt * a, axis=2)
    acs_t = jnp.moveaxis(acs, 2, -1)
    dt_t = jnp.moveaxis(dt, 2, -1)
    causal = jnp.tril(jnp.ones((l, l), dtype=bool))
    decay = jnp.exp(jnp.where(causal, acs_t[..., :, None] - acs_t[..., None, :], -jnp.inf))
    cb = jnp.einsum('bclgn,bcsgn->bcgls', cm, bm)
    w_intra = cb[:, :, :, None] * decay * dt_t[..., None, :]
    y_diag = jnp.einsum('bcgrls,bcsgrp->bclgrp', w_intra, x)
    xw = x * (jnp.exp(acs[:, :, -1:] - acs) * dt)[..., None]
    states = jnp.einsum('bclgn,bclgrp->bcgrpn', bm, xw)
    chunk_decay = jnp.exp(acs[:, :, -1])

    def step(h, inp):
        dec, st = inp
        return dec[..., None, None] * h + st, h

    h_init = h0.astype(f32).reshape(b, SSD_GROUPS, SSD_HPG, SSD_HEAD_DIM, SSD_D_STATE)
    h_last, h_prev = lax.scan(step, h_init, (jnp.moveaxis(chunk_decay, 1, 0), jnp.moveaxis(states, 1, 0)))
    h_prev = jnp.moveaxis(h_prev, 0, 1)
    y_off = jnp.einsum('bclgn,bcgrpn->bclgrp', cm, h_prev) * jnp.exp(acs)[..., None]
    y = y_diag + y_off + d_skip.astype(f32).reshape(SSD_GROUPS, SSD_HPG, 1) * x
    gsz = SSD_D_INNER // SSD_GROUPS
    y = y.reshape(b, L, SSD_GROUPS, gsz) * jax.nn.silu(z.astype(f32)).reshape(b, L, SSD_GROUPS, gsz)
    y = y * lax.rsqrt(jnp.mean(jnp.square(y), axis=-1, keepdims=True) + EPS)
    y = y.reshape(b, L, SSD_D_INNER) * ssd_norm.astype(f32)
    h_out = h_last.reshape(b, SSD_HEADS, SSD_HEAD_DIM, SSD_D_STATE)
    return y.astype(z.dtype), new_conv.astype(conv_buf.dtype), h_out.astype(h0.dtype)


def _mem_kv(mem, norm_mem, w_mem_kv, k_norm_mem):
    b, m, _ = mem.shape
    k, v = jnp.split(_rmsnorm(mem, norm_mem) @ w_mem_kv, 2, axis=-1)
    k = _rmsnorm(k.reshape(b, m, MEM_HEADS, MEM_HEAD_DIM), k_norm_mem)
    return k, v.reshape(b, m, MEM_HEADS, MEM_HEAD_DIM)


def _mem_attend(q, k, v):
    b, t = q.shape[:2]
    s = jnp.einsum('bthd,bmhd->bhtm', q, k).astype(jnp.float32) * (MEM_HEAD_DIM ** -0.5)
    p = jax.nn.softmax(s, axis=-1)
    o = jnp.einsum('bhtm,bmhd->bthd', p, v.astype(jnp.float32))
    return o.reshape(b, t, MEM_DIM).astype(q.dtype)


def _merge_ffn(x, a_out, s_out, m_out, gates, w_up_swa, w_up_ssd, w_up_mem, w_out, norm_ffn, w_gate, w_up, w_down):
    merged = (gates[:, :, 0] * (a_out @ w_up_swa)
              + gates[:, :, 1] * (s_out @ w_up_ssd)
              + gates[:, :, 2] * (m_out @ w_up_mem))
    x = x + merged @ w_out
    h = _rmsnorm(x, norm_ffn)
    return x + (jax.nn.silu(h @ w_gate) * (h @ w_up)) @ w_down


def setup_inputs(seed: int = 0) -> dict:
    key = jax.random.key(seed)
    ks = iter(jax.random.split(key, 48))
    f32 = jnp.float32

    def nrm(shape, scale=1.0):
        return jax.random.normal(next(ks), shape, f32) * scale

    def gain(n):
        return 1.0 + nrm((DEPTH, n), 0.02)

    w_buf = min(WINDOW, PAST_LEN)
    dt0 = jnp.exp(jax.random.uniform(next(ks), (DEPTH, SSD_HEADS), f32, math.log(1e-3), math.log(1e-1)))
    dt_bias = dt0 + jnp.log(-jnp.expm1(-dt0))
    a_log = jnp.log(jax.random.uniform(next(ks), (DEPTH, SSD_HEADS), f32, 1.0, 16.0))
    return {
        "x_prompt": nrm((BATCH, SEQ, D_MODEL)),
        "x_sample": nrm((DEC_BATCH, DEC_SEQ, D_MODEL)),
        "cache_swa_k": nrm((DEPTH, DEC_BATCH, w_buf, SWA_KV_HEADS, SWA_HEAD_DIM)),
        "cache_swa_v": nrm((DEPTH, DEC_BATCH, w_buf, SWA_KV_HEADS, SWA_HEAD_DIM)),
        "cache_mem_k": nrm((DEPTH, DEC_BATCH, MEM_TOKENS, MEM_HEADS, MEM_HEAD_DIM)),
        "cache_mem_v": nrm((DEPTH, DEC_BATCH, MEM_TOKENS, MEM_HEADS, MEM_HEAD_DIM)),
        "state_ssm": nrm((DEPTH, DEC_BATCH, SSD_HEADS, SSD_HEAD_DIM, SSD_D_STATE), 0.1),
        "state_conv": nrm((DEPTH, DEC_BATCH, SSD_CONV - 1, SSD_CONV_CH)),
        "mem_prompt": nrm((BATCH, MEM_TOKENS, D_MODEL)),
        "norm_mix": gain(D_MODEL),
        "w_in": nrm((DEPTH, D_MODEL, IN_DIM), D_MODEL ** -0.5),
        "q_norm_swa": gain(SWA_HEAD_DIM),
        "k_norm_swa": gain(SWA_HEAD_DIM),
        "swa_sinks": nrm((DEPTH, SWA_HEADS), 0.5),
        "conv_w": nrm((DEPTH, SSD_CONV, SSD_CONV_CH), SSD_CONV ** -0.5),
        "conv_b": nrm((DEPTH, SSD_CONV_CH), 0.01),
        "dt_bias": dt_bias,
        "a_log": a_log,
        "d_skip": 1.0 + nrm((DEPTH, SSD_HEADS), 0.02),
        "ssd_norm": gain(SSD_D_INNER),
        "norm_mem": gain(D_MODEL),
        "w_mem_kv": nrm((DEPTH, D_MODEL, 2 * MEM_DIM), D_MODEL ** -0.5),
        "q_norm_mem": gain(MEM_HEAD_DIM),
        "k_norm_mem": gain(MEM_HEAD_DIM),
        "w_up_swa": nrm((DEPTH, SWA_Q_DIM, D_MODEL), SWA_Q_DIM ** -0.5),
        "w_up_ssd": nrm((DEPTH, SSD_D_INNER, D_MODEL), SSD_D_INNER ** -0.5),
        "w_up_mem": nrm((DEPTH, MEM_DIM, D_MODEL), MEM_DIM ** -0.5),
        "w_out": nrm((DEPTH, D_MODEL, D_MODEL), D_MODEL ** -0.5),
        "norm_ffn": gain(D_MODEL),
        "w_gate": nrm((DEPTH, D_MODEL, D_FF), D_MODEL ** -0.5),
        "w_up": nrm((DEPTH, D_MODEL, D_FF), D_MODEL ** -0.5),
        "w_down": nrm((DEPTH, D_FF, D_MODEL), D_FF ** -0.5),
    }


def reference(x_prompt, x_sample, cache_swa_k, cache_swa_v, cache_mem_k, cache_mem_v, state_ssm, state_conv,
              mem_prompt, norm_mix, w_in, q_norm_swa, k_norm_swa, swa_sinks, conv_w, conv_b, dt_bias, a_log,
              d_skip, ssd_norm, norm_mem, w_mem_kv, q_norm_mem, k_norm_mem, w_up_swa, w_up_ssd, w_up_mem,
              w_out, norm_ffn, w_gate, w_up, w_down):
    bp, tp, _ = x_prompt.shape
    bs, ts, _ = x_sample.shape
    w_buf = cache_swa_k.shape[2]
    w_p = min(WINDOW, tp)
    yp, ys = x_prompt, x_sample
    p_k, p_v, p_mk, p_mv, p_h, p_c = [], [], [], [], [], []
    s_k, s_v, s_h, s_c = [], [], [], []
    for l in range(DEPTH):
        ssd_w = (conv_w[l], conv_b[l], dt_bias[l], a_log[l], d_skip[l], ssd_norm[l])
        out_w = (w_up_swa[l], w_up_ssd[l], w_up_mem[l], w_out[l], norm_ffn[l], w_gate[l], w_up[l], w_down[l])

        q, k, v, z, xbc, dt, qm, gates = _in_proj(yp, norm_mix[l], w_in[l], q_norm_swa[l], k_norm_swa[l], q_norm_mem[l])
        a_out = _swa_prompt(q, k, v, swa_sinks[l])
        conv0 = jnp.zeros((bp, SSD_CONV - 1, SSD_CONV_CH), state_conv.dtype)
        h0 = jnp.zeros((bp, SSD_HEADS, SSD_HEAD_DIM, SSD_D_STATE), state_ssm.dtype)
        s_out, conv_new, h_new = _ssd(xbc, z, dt, conv0, h0, *ssd_w)
        mk, mv = _mem_kv(mem_prompt, norm_mem[l], w_mem_kv[l], k_norm_mem[l])
        m_out = _mem_attend(qm, mk, mv)
        yp = _merge_ffn(yp, a_out, s_out, m_out, gates, *out_w)
        p_k.append(k[:, tp - w_p:])
        p_v.append(v[:, tp - w_p:])
        p_mk.append(mk)
        p_mv.append(mv)
        p_h.append(h_new)
        p_c.append(conv_new)

        q, k, v, z, xbc, dt, qm, gates = _in_proj(ys, norm_mix[l], w_in[l], q_norm_swa[l], k_norm_swa[l], q_norm_mem[l])
        k_all = jnp.concatenate([cache_swa_k[l].astype(k.dtype), k], axis=1)
        v_all = jnp.concatenate([cache_swa_v[l].astype(v.dtype), v], axis=1)
        k_pos = PAST_LEN - w_buf + jnp.arange(w_buf + ts, dtype=jnp.int32)
        q_pos = PAST_LEN + jnp.arange(ts, dtype=jnp.int32)
        a_out = _swa_attend(q, k_all, v_all, q_pos, k_pos, swa_sinks[l]).reshape(bs, ts, SWA_Q_DIM)
        s_out, conv_new, h_new = _ssd(xbc, z, dt, state_conv[l], state_ssm[l], *ssd_w)
        m_out = _mem_attend(qm, cache_mem_k[l], cache_mem_v[l])
        ys = _merge_ffn(ys, a_out, s_out, m_out, gates, *out_w)
        s_k.append(k_all[:, ts:])
        s_v.append(v_all[:, ts:])
        s_h.append(h_new)
        s_c.append(conv_new)

    return (yp, ys,
            jnp.stack(p_k), jnp.stack(p_v), jnp.stack(p_mk), jnp.stack(p_mv), jnp.stack(p_h), jnp.stack(p_c),
            jnp.stack(s_k), jnp.stack(s_v), jnp.stack(s_h), jnp.stack(s_c))
```

```cpp
#include <hip/hip_runtime.h>
#include <hip/hip_cooperative_groups.h>
#include <cstdio>
#include <cstdint>
namespace cg = cooperative_groups;
namespace pg8 {
#define PG8_LAS __attribute__((address_space(3)))
typedef unsigned short bf16_t;
typedef short bf16x8 __attribute__((ext_vector_type(8)));
typedef float f32x4 __attribute__((ext_vector_type(4)));
typedef unsigned u32x4 __attribute__((ext_vector_type(4)));
constexpr int BM = 256, BK = 64, HALF = 128, HTB = HALF * BK * 2  , STAGE_BYTES = 8 * HTB, NXCD = 8, WGM = 8;

__host__ __device__ __forceinline__ int lds_byte(int r, int c) { const int st = (r >> 4) * 2 + (c >> 5), rr = r & 15, cc = c & 31, ob = rr * 64 + cc * 2; return st * 1024 + (ob ^ (((ob >> 9) & 1) << 5)); }
__host__ __device__ __forceinline__ void stage_rc(int b, int& R, int& C) { const int st = b / 1024, sb = b % 1024, swz = sb ^ (((sb >> 9) & 1) << 5); R = (st >> 1) * 16 + swz / 64; C = (st & 1) * 32 + (swz % 64) / 2; }
__host__ __device__ __forceinline__ int perm32(int rho) { const int n = rho >> 4, i = rho & 15; return 8 * (i >> 2) + 4 * n + (i & 3); }

struct Unit { int pm, pn; };
struct Gemm { const bf16_t* A; const bf16_t* Bt; int M, N, K; };
struct StaticOrder {
    int nM, nN, nwg, G, c;
    __host__ __device__ void init(int M, int N, int G_, int c_) { nM = M / BM; nN = N / BM; nwg = nM * nN; G = G_; c = c_; }
    __host__ __device__ bool next(int i, Unit& u) const {
        const long L = (long)i * G + c; if (L >= nwg) return false;
        int wgid = (int)L; { const int q = nwg / NXCD, r = nwg % NXCD, xcd = wgid % NXCD, off = wgid / NXCD; wgid = (xcd < r ? xcd * (q + 1) : r * (q + 1) + (xcd - r) * q) + off; }
        const int nig = WGM * nN, gid = wgid / nig, fm = gid * WGM, gsz = (nM - fm) < WGM ? (nM - fm) : WGM;
        u.pm = fm + ((wgid % nig) % gsz); u.pn = (wgid % nig) / gsz; return true;
    }
    __device__ __forceinline__ void a_ready(const Unit&) const {}
    __device__ __forceinline__ void done(const Unit&) const {}
};

__device__ __forceinline__ unsigned cvt_pk_bf16(float lo, float hi) { unsigned r; asm volatile("v_cvt_pk_bf16_f32 %0, %1, %2" : "=v"(r) : "v"(lo), "v"(hi)); return r; }
typedef float f32x2 __attribute__((ext_vector_type(2)));
template <class Epi, class Sched, bool ALIGN_EPI = false, bool SP2 = false>
__device__ __forceinline__ void gemm_phase(PG8_LAS unsigned char* lds, const Gemm g, const Sched& S, const Epi& E) {
    const int tid = threadIdx.x, wid = __builtin_amdgcn_readfirstlane(tid >> 6), lane = tid & 63, wr = wid >> 2, wc = wid & 3, fr = lane & 15, fq = lane >> 4;
    const int K = g.K, nt = K / BK;
    unsigned voffA[2], voffB[2];
#pragma unroll
    for (int i = 0; i < 2; ++i) { int R, C; stage_rc(tid * 16 + i * 8192, R, C); const int Rb = Epi::PERM ? ((R & ~31) + perm32(R & 31)) : R;
        voffA[i] = (unsigned)(R * K + C) * 2u; voffB[i] = (unsigned)(Rb * K + C) * 2u; }
    const size_t kstep = (size_t)(BK * 2);
    const size_t hstep = (size_t)HALF * K * 2;
    const size_t tstep = 2 * hstep;
    const unsigned ldsw = (unsigned)wid * 1024u;
    const int aoff = lds_byte(wr * 64 + fr, fq * 8), boff = lds_byte(wc * 32 + fr, fq * 8);
#define PG8_SA(b, h) (((b) * 2 + (h)) * HTB)
#define PG8_SB(b, h) ((4 + (b) * 2 + (h)) * HTB)
#define PG8_STAGE(bufoff, gbase, voff) do { _Pragma("unroll") for (int _i = 0; _i < 2; ++_i) \
        __builtin_amdgcn_global_load_lds((const unsigned*)((const char*)(gbase) + (voff)[_i]), (PG8_LAS unsigned*)(lds + (bufoff) + ldsw + _i * 8192), 16, 0, 0); } while (0)
#define PG8_LDA(dst, b, h) do { _Pragma("unroll") for (int m = 0; m < 4; ++m) _Pragma("unroll") for (int k = 0; k < 2; ++k) dst[m][k] = *(const PG8_LAS bf16x8*)(lds + PG8_SA(b, h) + aoff + m * 2048 + k * 1024); } while (0)
#define PG8_LDB(dst, b, h) do { _Pragma("unroll") for (int n = 0; n < 2; ++n) _Pragma("unroll") for (int k = 0; k < 2; ++k) dst[n][k] = *(const PG8_LAS bf16x8*)(lds + PG8_SB(b, h) + boff + n * 2048 + k * 1024); } while (0)
#define PG8_MMA(ai, bj, At, Bt) do { __builtin_amdgcn_s_setprio(1); _Pragma("unroll") for (int m = 0; m < 4; ++m) _Pragma("unroll") for (int n = 0; n < 2; ++n) _Pragma("unroll") for (int k = 0; k < 2; ++k) \
        acc[ai][bj][m][n] = __builtin_amdgcn_mfma_f32_16x16x32_bf16(Bt[n][k], At[m][k], acc[ai][bj][m][n], 0, 0, 0); __builtin_amdgcn_s_setprio(0); } while (0)
#define PG8_WAIT_V(n) asm volatile("s_waitcnt vmcnt(" #n ")" ::: "memory")
#define PG8_WAIT_L(n) asm volatile("s_waitcnt lgkmcnt(" #n ")" ::: "memory")
#define PG8_BAR __builtin_amdgcn_s_barrier()
#define PG8_SCHED __builtin_amdgcn_sched_barrier(0)
    Unit cur, nxt; int ui = 0;
    if (!S.next(0, cur)) return;
    f32x4 acc[2][2][4][2];
#pragma unroll
    for (int a = 0; a < 2; ++a)
#pragma unroll
        for (int b = 0; b < 2; ++b)
#pragma unroll
            for (int m = 0; m < 4; ++m)
#pragma unroll
                for (int n = 0; n < 2; ++n) acc[a][b][m][n] = (f32x4){0.f, 0.f, 0.f, 0.f};
    bf16x8 At[4][2], B0[2][2], B1[2][2];
    const char* cA = (const char*)g.A + (size_t)cur.pm * tstep; const char* cB = (const char*)g.Bt + (size_t)cur.pn * tstep;
    S.a_ready(cur);
    if constexpr (SP2) {
        PG8_STAGE(PG8_SB(0, 0), cB, voffB); PG8_STAGE(PG8_SB(0, 1), cB + hstep, voffB); PG8_STAGE(PG8_SA(0, 0), cA, voffA); PG8_STAGE(PG8_SA(0, 1), cA + hstep, voffA);
        if (wr == 1) PG8_BAR;
        PG8_WAIT_V(2); PG8_BAR;
        PG8_STAGE(PG8_SB(1, 0), cB + kstep, voffB); PG8_STAGE(PG8_SA(1, 0), cA + kstep, voffA); PG8_STAGE(PG8_SB(1, 1), cB + hstep + kstep, voffB);
        PG8_WAIT_V(6); PG8_BAR;
    } else {
        PG8_STAGE(PG8_SB(0, 0), cB, voffB); PG8_STAGE(PG8_SA(0, 0), cA, voffA); PG8_STAGE(PG8_SB(0, 1), cB + hstep, voffB); PG8_STAGE(PG8_SA(0, 1), cA + hstep, voffA);
        if (wr == 1) PG8_BAR;
        PG8_WAIT_V(4); PG8_BAR;
        PG8_STAGE(PG8_SB(1, 0), cB + kstep, voffB); PG8_STAGE(PG8_SA(1, 0), cA + kstep, voffA); PG8_STAGE(PG8_SB(1, 1), cB + hstep + kstep, voffB);
        PG8_WAIT_V(6); PG8_BAR;
    }
    for (;;) {
        const bool has_next = S.next(ui + 1, nxt);
        const char* nA = has_next ? (const char*)g.A + (size_t)nxt.pm * tstep : cA; const char* nB = has_next ? (const char*)g.Bt + (size_t)nxt.pn * tstep : cB;
        for (int t = 0; t < nt; t += 2) {
            const bool last = (t == nt - 2);
            const char* a1 = cA + (size_t)(t + 1) * kstep;
            const char* a2 = last ? nA : cA + (size_t)(t + 2) * kstep; const char* b2 = last ? nB : cB + (size_t)(t + 2) * kstep;
            const char* a3 = a2 + kstep; const char* b3 = b2 + kstep;
            if (last && has_next) S.a_ready(nxt);
            if constexpr (SP2) {
            PG8_LDB(B0, 0, 0); PG8_LDB(B1, 0, 1); PG8_SCHED; PG8_LDA(At, 0, 0); PG8_STAGE(PG8_SA(1, 1), a1 + hstep, voffA);
            PG8_WAIT_V(8); PG8_WAIT_L(0); PG8_BAR; PG8_MMA(0, 0, At, B0); PG8_MMA(0, 1, At, B1); PG8_BAR; PG8_SCHED;
            PG8_LDA(At, 0, 1); PG8_STAGE(PG8_SB(0, 0), b2, voffB); PG8_STAGE(PG8_SB(0, 1), b2 + hstep, voffB); PG8_STAGE(PG8_SA(0, 0), a2, voffA);
            PG8_WAIT_V(8); PG8_WAIT_L(0); PG8_BAR; PG8_MMA(1, 0, At, B0); PG8_MMA(1, 1, At, B1); PG8_BAR; PG8_SCHED;
            PG8_LDB(B0, 1, 0); PG8_LDB(B1, 1, 1); PG8_SCHED; PG8_LDA(At, 1, 0); PG8_STAGE(PG8_SA(0, 1), a2 + hstep, voffA);
            PG8_WAIT_V(8); PG8_WAIT_L(0); PG8_BAR; PG8_MMA(0, 0, At, B0); PG8_MMA(0, 1, At, B1); PG8_BAR; PG8_SCHED;
            PG8_LDA(At, 1, 1); PG8_STAGE(PG8_SB(1, 0), b3, voffB); PG8_STAGE(PG8_SB(1, 1), b3 + hstep, voffB); PG8_STAGE(PG8_SA(1, 0), a3, voffA);
            PG8_WAIT_V(8); PG8_WAIT_L(0); PG8_BAR; PG8_MMA(1, 0, At, B0); PG8_MMA(1, 1, At, B1); PG8_BAR; PG8_SCHED;
            } else {
            PG8_LDB(B0, 0, 0); PG8_SCHED; PG8_LDA(At, 0, 0); PG8_STAGE(PG8_SA(1, 1), a1 + hstep, voffA);
            PG8_WAIT_L(8); PG8_BAR; PG8_WAIT_L(0); PG8_MMA(0, 0, At, B0); PG8_BAR; PG8_SCHED;
            PG8_LDB(B1, 0, 1); PG8_STAGE(PG8_SB(0, 0), b2, voffB);
            PG8_BAR; PG8_WAIT_L(0); PG8_MMA(0, 1, At, B1); PG8_BAR;
            PG8_LDA(At, 0, 1); PG8_STAGE(PG8_SA(0, 0), a2, voffA);
            PG8_BAR; PG8_WAIT_L(0); PG8_MMA(1, 0, At, B0); PG8_BAR; PG8_SCHED;
            PG8_STAGE(PG8_SB(0, 1), b2 + hstep, voffB);
            PG8_WAIT_V(6); PG8_BAR; PG8_MMA(1, 1, At, B1); PG8_BAR;
            PG8_LDB(B0, 1, 0); PG8_SCHED; PG8_LDA(At, 1, 0); PG8_STAGE(PG8_SA(0, 1), a2 + hstep, voffA);
            PG8_WAIT_L(8); PG8_BAR; PG8_WAIT_L(0); PG8_MMA(0, 0, At, B0); PG8_BAR; PG8_SCHED;
            PG8_LDB(B1, 1, 1); PG8_STAGE(PG8_SB(1, 0), b3, voffB);
            PG8_BAR; PG8_WAIT_L(0); PG8_MMA(0, 1, At, B1); PG8_BAR;
            PG8_LDA(At, 1, 1); PG8_STAGE(PG8_SA(1, 0), a3, voffA);
            PG8_BAR; PG8_WAIT_L(0); PG8_MMA(1, 0, At, B0); PG8_BAR; PG8_SCHED;
            PG8_STAGE(PG8_SB(1, 1), b3 + hstep, voffB);
            PG8_WAIT_V(6); PG8_BAR; PG8_MMA(1, 1, At, B1); PG8_BAR;
            }
        }
        if constexpr (ALIGN_EPI) { if (wr == 0) PG8_BAR; }
        if constexpr (!Epi::AFTER_DRAIN) { E(acc, cur, wr, wc, fr, fq); S.done(cur); }
        if (!has_next) break;
#pragma unroll
        for (int a = 0; a < 2; ++a)
#pragma unroll
            for (int b = 0; b < 2; ++b)
#pragma unroll
                for (int m = 0; m < 4; ++m)
#pragma unroll
                    for (int n = 0; n < 2; ++n) acc[a][b][m][n] = (f32x4){0.f, 0.f, 0.f, 0.f};
        cur = nxt; cA = nA; cB = nB; ++ui;
        if constexpr (ALIGN_EPI) { if (wr == 1) PG8_BAR; }
    }
    PG8_WAIT_V(0);
    if constexpr (!ALIGN_EPI) { if (wr == 0) PG8_BAR; }
    PG8_BAR;
    if constexpr (Epi::AFTER_DRAIN) { E.fused(acc, cur, wr, wc, fr, fq, lds, wid, lane); S.done(cur); }
#undef PG8_SA
#undef PG8_SB
#undef PG8_STAGE
#undef PG8_LDA
#undef PG8_LDB
#undef PG8_MMA
#undef PG8_WAIT_V
#undef PG8_WAIT_L
#undef PG8_BAR
#undef PG8_SCHED
}
}

#ifndef PG8_SP2
#define PG8_SP2 true
#endif
#ifndef PG8_ALIGN
#define PG8_ALIGN true
#endif

#define LAS __attribute__((address_space(3)))
typedef unsigned short bf16;
typedef short bf16x8 __attribute__((ext_vector_type(8)));
typedef float f32x4 __attribute__((ext_vector_type(4)));
typedef unsigned v4u __attribute__((ext_vector_type(4)));
typedef unsigned v2u __attribute__((ext_vector_type(2)));

constexpr int DM = 2048, SEQ = 2048, NBATCH = 16, MP = NBATCH * SEQ, MS = 128, MTOK = MP + MS, MPAD = 33024;
constexpr int NA = 7936, NG = 6144, NIN = 14080, DFF = 5632, CONVCH = 3072;
constexpr int CQ = 0, CK = 1024, CV = 1280, CZ = 1536, CXBC = 3584, CDT = 6656, CQM = 6912;
constexpr float EPS = 1e-6f;
constexpr int LDS_BYTES = 147456;

constexpr size_t O_YP = 0, O_YS = O_YP + (size_t)MP * DM, O_PK = O_YS + (size_t)MS * DM, O_PV = O_PK + 524288, O_PMK = O_PV + 524288, O_PMV = O_PMK + 4194304,
                 O_PSSM = O_PMV + 4194304, O_PCONV = O_PSSM + 4194304, O_SK = O_PCONV + 147456, O_SV = O_SK + 4194304, O_SSSM = O_SV + 4194304, O_SCONV = O_SSSM + 33554432,
                 O_END = O_SCONV + 1179648;
constexpr size_t WS_WIN = 0, WS_WM = WS_WIN + (size_t)NIN * 2048 * 2, WS_WSWA = WS_WM + 2048u * 2048 * 2, WS_WSSD = WS_WSWA + 2048u * 1024 * 2, WS_WMEM = WS_WSSD + 2048u * 2048 * 2,
                 WS_WOUT = WS_WMEM + 2048u * 1024 * 2, WS_WGU = WS_WOUT + 2048u * 2048 * 2, WS_WD = WS_WGU + (size_t)2 * DFF * 2048 * 2, WS_XB = WS_WD + (size_t)2048 * DFF * 2,
                 WS_MB = WS_XB + (size_t)MPAD * 2048 * 2, WS_MKV = WS_MB + 4096u * 2048 * 2, WS_BIG = WS_MKV + 4096u * 2048 * 2, WS_MO = WS_BIG + (size_t)MPAD * NA * 2,
                 WS_DT = WS_MO + (size_t)MPAD * 1024 * 2, WS_SSQ = WS_DT + (size_t)MPAD * 32 * 4, WS_RS1 = WS_SSQ + (size_t)MPAD * 32 * 4, WS_RSM = WS_RS1 + (size_t)MPAD * 4,
                 WS_PART = WS_RSM + 4096u * 4, WS_END = WS_PART + (size_t)MPAD * 32 * 4;
constexpr size_t BIG_ACT = 0, BIG_X1B = (size_t)MPAD * DFF * 2;
static_assert(BIG_X1B + (size_t)MPAD * 2048 * 2 <= (size_t)MPAD * NA * 2, "big overlay");
constexpr size_t YP_AO = 0, YP_SO = (size_t)MPAD * 1024 * 2;
static_assert(YP_SO + (size_t)MPAD * 2048 * 2 <= (size_t)MP * DM * 4, "AO/SO fit in y_prompt");

struct KP { const float* in[32]; float* out; unsigned char* ws; int ph_lo, ph_hi; };

__device__ __forceinline__ float bf2f(unsigned v) { return __uint_as_float(v << 16); }
__device__ __forceinline__ unsigned f2bf(float f) { unsigned u = __float_as_uint(f); return (u + 0x7fffu + ((u >> 16) & 1u)) >> 16; }
__device__ __forceinline__ unsigned pk2(float lo, float hi) { return f2bf(lo) | (f2bf(hi) << 16); }
__device__ __forceinline__ float lo16(unsigned w) { return __uint_as_float(w << 16); }
__device__ __forceinline__ float hi16(unsigned w) { return __uint_as_float(w & 0xffff0000u); }
__device__ __forceinline__ float sigmoidf_(float x) { return 1.0f / (1.0f + __expf(-x)); }
__device__ __forceinline__ float siluf_(float x) { return x / (1.0f + __expf(-x)); }
__device__ __forceinline__ float wave_sum(float v) {
#pragma unroll
    for (int o = 1; o < 64; o <<= 1) v += __shfl_xor(v, o);
    return v;
}
__device__ __forceinline__ float wave_max(float v) {
#pragma unroll
    for (int o = 1; o < 64; o <<= 1) v = fmaxf(v, __shfl_xor(v, o));
    return v;
}
__device__ __forceinline__ f32x4 mfma16(bf16x8 a, bf16x8 b, f32x4 c) { return __builtin_amdgcn_mfma_f32_16x16x32_bf16(a, b, c, 0, 0, 0); }
#define UNPACK8(W_, F_) do { F_[0] = lo16((W_)[0]); F_[1] = hi16((W_)[0]); F_[2] = lo16((W_)[1]); F_[3] = hi16((W_)[1]); F_[4] = lo16((W_)[2]); F_[5] = hi16((W_)[2]); F_[6] = lo16((W_)[3]); F_[7] = hi16((W_)[3]); } while (0)

template <int ACT> struct EpiProj {
    static constexpr bool PERM = true, AFTER_DRAIN = false;
    bf16* O; int ldc; const float* rs; float* f32o; int fc0, fw, fld;
    __device__ __forceinline__ void operator()(const pg8::f32x4 (&acc)[2][2][4][2], const pg8::Unit& u, int wr, int wc, int fr, int fq) const {
#pragma unroll
        for (int ai = 0; ai < 2; ++ai)
#pragma unroll
            for (int m = 0; m < 4; ++m) {
                const int row = u.pm * 256 + ai * 128 + wr * 64 + m * 16 + fr; const float s = rs[row];
#pragma unroll
                for (int bj = 0; bj < 2; ++bj) {
                    const int col = u.pn * 256 + bj * 128 + wc * 32 + 8 * fq;
                    f32x4 v0 = acc[ai][bj][m][0] * s, v1 = acc[ai][bj][m][1] * s;
                    if (ACT == 1) { v0[0] = sigmoidf_(v0[0]); v0[1] = sigmoidf_(v0[1]); v0[2] = sigmoidf_(v0[2]); v0[3] = sigmoidf_(v0[3]);
                                    v1[0] = sigmoidf_(v1[0]); v1[1] = sigmoidf_(v1[1]); v1[2] = sigmoidf_(v1[2]); v1[3] = sigmoidf_(v1[3]); }
                    v4u w; w.x = pk2(v0[0], v0[1]); w.y = pk2(v0[2], v0[3]); w.z = pk2(v1[0], v1[1]); w.w = pk2(v1[2], v1[3]);
                    *(v4u*)(O + (size_t)row * ldc + col) = w;
                    if (f32o && col >= fc0 && col < fc0 + fw) { float* d = f32o + (size_t)row * fld + (col - fc0); *(f32x4*)d = v0; *(f32x4*)(d + 4) = v1; }
                }
            }
    }
};
template <int ACCUM> struct EpiMerge {
    static constexpr bool PERM = true, AFTER_DRAIN = false;
    bf16* MG; const bf16* G;
    __device__ __forceinline__ void operator()(const pg8::f32x4 (&acc)[2][2][4][2], const pg8::Unit& u, int wr, int wc, int fr, int fq) const {
#pragma unroll
        for (int ai = 0; ai < 2; ++ai)
#pragma unroll
            for (int m = 0; m < 4; ++m) {
                const int row = u.pm * 256 + ai * 128 + wr * 64 + m * 16 + fr;
#pragma unroll
                for (int bj = 0; bj < 2; ++bj) {
                    const int col = u.pn * 256 + bj * 128 + wc * 32 + 8 * fq;
                    const v4u gw = *(const v4u*)(G + (size_t)row * NG + col);
                    float g[8]; UNPACK8(gw, g);
                    const f32x4 a0 = acc[ai][bj][m][0], a1 = acc[ai][bj][m][1];
                    float v[8] = {g[0] * a0[0], g[1] * a0[1], g[2] * a0[2], g[3] * a0[3], g[4] * a1[0], g[5] * a1[1], g[6] * a1[2], g[7] * a1[3]};
                    bf16* dst = MG + (size_t)row * 2048 + col;
                    if (ACCUM) { const v4u ow = *(const v4u*)dst; float o[8]; UNPACK8(ow, o);
#pragma unroll
                        for (int e = 0; e < 8; ++e) v[e] += o[e]; }
                    v4u w; w.x = pk2(v[0], v[1]); w.y = pk2(v[2], v[3]); w.z = pk2(v[4], v[5]); w.w = pk2(v[6], v[7]);
                    *(v4u*)dst = w;
                }
            }
    }
};
struct EpiWout {
    static constexpr bool PERM = true, AFTER_DRAIN = false;
    const float* xp; const float* xs; float* yp; float* ys; bf16* X1B; float* part;
    __device__ __forceinline__ void operator()(const pg8::f32x4 (&acc)[2][2][4][2], const pg8::Unit& u, int wr, int wc, int fr, int fq) const {
#pragma unroll
        for (int ai = 0; ai < 2; ++ai)
#pragma unroll
            for (int m = 0; m < 4; ++m) {
                const int row = u.pm * 256 + ai * 128 + wr * 64 + m * 16 + fr;
                const float* xr = row < MP ? xp + (size_t)row * DM : xs + (size_t)(row - MP) * DM;
                float* yr = row < MP ? yp + (size_t)row * DM : ys + (size_t)(row - MP) * DM;
                const bool live = row < MTOK;
                float ps = 0.f;
#pragma unroll
                for (int bj = 0; bj < 2; ++bj) {
                    const int col = u.pn * 256 + bj * 128 + wc * 32 + 8 * fq;
                    f32x4 v0 = {0.f, 0.f, 0.f, 0.f}, v1 = {0.f, 0.f, 0.f, 0.f};
                    if (live) { v0 = *(const f32x4*)(xr + col) + acc[ai][bj][m][0]; v1 = *(const f32x4*)(xr + col + 4) + acc[ai][bj][m][1];
                                *(f32x4*)(yr + col) = v0; *(f32x4*)(yr + col + 4) = v1; }
                    v4u w; w.x = pk2(v0[0], v0[1]); w.y = pk2(v0[2], v0[3]); w.z = pk2(v1[0], v1[1]); w.w = pk2(v1[2], v1[3]);
                    *(v4u*)(X1B + (size_t)row * DM + col) = w;
                    ps += (v0[0] * v0[0] + v0[1] * v0[1]) + (v0[2] * v0[2] + v0[3] * v0[3]) + (v1[0] * v1[0] + v1[1] * v1[1]) + (v1[2] * v1[2] + v1[3] * v1[3]);
                }
                ps += __shfl_xor(ps, 16); ps += __shfl_xor(ps, 32);
                if (fq == 0) part[(size_t)row * 32 + u.pn * 4 + wc] = ps;
            }
    }
};
struct EpiFfnUp {
    static constexpr bool PERM = true, AFTER_DRAIN = false;
    const float* part; bf16* ACT;
    __device__ __forceinline__ void operator()(const pg8::f32x4 (&acc)[2][2][4][2], const pg8::Unit& u, int wr, int wc, int fr, int fq) const {
#pragma unroll
        for (int ai = 0; ai < 2; ++ai)
#pragma unroll
            for (int m = 0; m < 4; ++m) {
                const int row = u.pm * 256 + ai * 128 + wr * 64 + m * 16 + fr;
                const f32x4* pp = (const f32x4*)(part + (size_t)row * 32);
                float ss = 0.f;
#pragma unroll
                for (int i = 0; i < 8; ++i) { const f32x4 t = pp[i]; ss += (t[0] + t[1]) + (t[2] + t[3]); }
                const float rs = rsqrtf(ss * (1.0f / DM) + EPS);
                const f32x4 g0 = acc[ai][0][m][0] * rs, g1 = acc[ai][0][m][1] * rs, u0 = acc[ai][1][m][0] * rs, u1 = acc[ai][1][m][1] * rs;
                v4u w; w.x = pk2(siluf_(g0[0]) * u0[0], siluf_(g0[1]) * u0[1]); w.y = pk2(siluf_(g0[2]) * u0[2], siluf_(g0[3]) * u0[3]);
                w.z = pk2(siluf_(g1[0]) * u1[0], siluf_(g1[1]) * u1[1]); w.w = pk2(siluf_(g1[2]) * u1[2], siluf_(g1[3]) * u1[3]);
                *(v4u*)(ACT + (size_t)row * DFF + u.pn * 128 + wc * 32 + 8 * fq) = w;
            }
    }
};
struct EpiDown {
    static constexpr bool PERM = true, AFTER_DRAIN = false;
    float* yp; float* ys;
    __device__ __forceinline__ void operator()(const pg8::f32x4 (&acc)[2][2][4][2], const pg8::Unit& u, int wr, int wc, int fr, int fq) const {
#pragma unroll
        for (int ai = 0; ai < 2; ++ai)
#pragma unroll
            for (int m = 0; m < 4; ++m) {
                const int row = u.pm * 256 + ai * 128 + wr * 64 + m * 16 + fr;
                if (row < MTOK) {
                    float* yr = row < MP ? yp + (size_t)row * DM : ys + (size_t)(row - MP) * DM;
#pragma unroll
                    for (int bj = 0; bj < 2; ++bj) {
                        const int col = u.pn * 256 + bj * 128 + wc * 32 + 8 * fq;
                        *(f32x4*)(yr + col) = *(const f32x4*)(yr + col) + acc[ai][bj][m][0];
                        *(f32x4*)(yr + col + 4) = *(const f32x4*)(yr + col + 4) + acc[ai][bj][m][1];
                    }
                }
            }
    }
};

__device__ __forceinline__ int maprow(int mode, int n0) {
    if (mode == 1) return n0 < 6688 ? n0 : n0 + 224;
    if (mode == 2) return (n0 >> 7) * 256 + (n0 & 127);
    if (mode == 3) return (n0 >> 7) * 256 + 128 + (n0 & 127);
    return n0;
}
__device__ __forceinline__ void tr_item(const float* W, int K, int N, bf16* WT, const float* gain, int mode, LAS float* scr, int item, int lane) {
    const int nblk = N / 32, kb = item / nblk, nb = item % nblk, k0 = 64 * kb, n0 = 32 * nb;
#pragma unroll 8
    for (int i = 0; i < 32; ++i) { const int kk = 2 * i + (lane >> 5); float v = W[(size_t)(k0 + kk) * N + n0 + (lane & 31)]; if (gain) v *= gain[k0 + kk]; scr[kk * 33 + (lane & 31)] = v; }
    asm volatile("s_waitcnt lgkmcnt(0)" ::: "memory");
    const int c = lane & 7, d0 = maprow(mode, n0);
#pragma unroll
    for (int j = 0; j < 4; ++j) { const int n = (lane >> 3) + 8 * j; const LAS float* s = scr + (8 * c) * 33 + n;
        v4u o; o.x = pk2(s[0 * 33], s[1 * 33]); o.y = pk2(s[2 * 33], s[3 * 33]); o.z = pk2(s[4 * 33], s[5 * 33]); o.w = pk2(s[6 * 33], s[7 * 33]);
        *(v4u*)(WT + (size_t)(d0 + n) * K + k0 + 8 * c) = o; }
    asm volatile("s_waitcnt lgkmcnt(0)" ::: "memory");
}
__device__ __forceinline__ void row_to_bf16(const float* xrow, bf16* orow, float* rs, int lane) {
    f32x4 v[8]; float s = 0.f;
#pragma unroll
    for (int j = 0; j < 8; ++j) { v[j] = *((const f32x4*)xrow + lane + 64 * j); s += (v[j][0] * v[j][0] + v[j][1] * v[j][1]) + (v[j][2] * v[j][2] + v[j][3] * v[j][3]); }
    s = wave_sum(s);
    if (lane == 0) *rs = rsqrtf(s * (1.0f / DM) + EPS);
#pragma unroll
    for (int j = 0; j < 8; ++j) { v2u w; w.x = pk2(v[j][0], v[j][1]); w.y = pk2(v[j][2], v[j][3]); *((v2u*)orow + lane + 64 * j) = w; }
}
__device__ __forceinline__ void prologue(const KP& p, LAS unsigned char* lds) {
    const int tid = threadIdx.x, lane = tid & 63, wave = tid >> 6;
    const int gw = blockIdx.x * 8 + wave, NGW = gridDim.x * 8;
    unsigned char* ws = p.ws;
    LAS float* scr = (LAS float*)(lds + wave * 8448);
    constexpr int I_IN = 32 * 433, I_G = 32 * 176, I_D = 88 * 64, I_M = 32 * 64, I_S = 16 * 64;
    constexpr int NITEMS = I_IN + 2 * I_G + I_D + I_M + I_S + I_M + I_S + I_M;
    for (int it = gw; it < NITEMS; it += NGW) {
        int r = it;
        if (r < I_IN) { tr_item(p.in[10], 2048, 13856, (bf16*)(ws + WS_WIN), p.in[9], 1, scr, r, lane); continue; } r -= I_IN;
        if (r < I_G) { tr_item(p.in[29], 2048, DFF, (bf16*)(ws + WS_WGU), p.in[28], 2, scr, r, lane); continue; } r -= I_G;
        if (r < I_G) { tr_item(p.in[30], 2048, DFF, (bf16*)(ws + WS_WGU), p.in[28], 3, scr, r, lane); continue; } r -= I_G;
        if (r < I_D) { tr_item(p.in[31], DFF, 2048, (bf16*)(ws + WS_WD), nullptr, 0, scr, r, lane); continue; } r -= I_D;
        if (r < I_M) { tr_item(p.in[21], 2048, 2048, (bf16*)(ws + WS_WM), p.in[20], 0, scr, r, lane); continue; } r -= I_M;
        if (r < I_S) { tr_item(p.in[24], 1024, 2048, (bf16*)(ws + WS_WSWA), nullptr, 0, scr, r, lane); continue; } r -= I_S;
        if (r < I_M) { tr_item(p.in[25], 2048, 2048, (bf16*)(ws + WS_WSSD), p.in[19], 0, scr, r, lane); continue; } r -= I_M;
        if (r < I_S) { tr_item(p.in[26], 1024, 2048, (bf16*)(ws + WS_WMEM), nullptr, 0, scr, r, lane); continue; } r -= I_S;
        tr_item(p.in[27], 2048, 2048, (bf16*)(ws + WS_WOUT), nullptr, 0, scr, r, lane);
    }
    { v4u* z = (v4u*)((bf16*)(ws + WS_WIN) + (size_t)6688 * 2048); const int nz = 224 * 2048 / 8; const v4u zero = {0u, 0u, 0u, 0u};
      for (int i = blockIdx.x * 512 + tid; i < nz; i += gridDim.x * 512) z[i] = zero; }
    bf16* XB = (bf16*)(ws + WS_XB); float* RS1 = (float*)(ws + WS_RS1);
    for (int r = gw; r < MPAD; r += NGW) {
        if (r < MTOK) { const float* src = r < MP ? p.in[0] + (size_t)r * DM : p.in[1] + (size_t)(r - MP) * DM; row_to_bf16(src, XB + (size_t)r * DM, RS1 + r, lane); }
        else { const v2u zero = {0u, 0u};
#pragma unroll
            for (int j = 0; j < 8; ++j) *((v2u*)(XB + (size_t)r * DM) + lane + 64 * j) = zero;
            if (lane == 0) RS1[r] = 0.f; }
    }
    bf16* MB = (bf16*)(ws + WS_MB); float* RSM = (float*)(ws + WS_RSM);
    for (int r = gw; r < 4096; r += NGW) row_to_bf16(p.in[8] + (size_t)r * DM, MB + (size_t)r * DM, RSM + r, lane);
}

#define LDSP(T, off) ((LAS T*)(lds + (off)))

__device__ __forceinline__ void swa_prompt_item(const KP& p, LAS unsigned char* lds, int item) {
    const int tid = threadIdx.x, lane = tid & 63, w = tid >> 6, fr = lane & 15, fq = lane >> 4;
    const int h = item & 15, blk = (item >> 4) & 15, b = item >> 8, kvh = h >> 2;
    LAS bf16* Qs = LDSP(bf16, 0);
    LAS bf16* Ks = LDSP(bf16, 18432);
    LAS bf16* Vt = LDSP(bf16, 57600);
    LAS bf16* Ps = LDSP(bf16, 93440) + w * (16 * 168);
    const bf16* PA = (const bf16*)(p.ws + WS_BIG);
    bf16* AO = (bf16*)((unsigned char*)(p.out + O_YP) + YP_AO);
    const float* qw = p.in[11]; const float* kw = p.in[12];
    {
        const int c = tid >> 1, half = tid & 1, s = (blk - 1) * 128 + c;
        v4u kz[4], vz[4];
        if (s >= 0) { const bf16* src = PA + (size_t)(b * SEQ + s) * NA + kvh * 64 + half * 32;
#pragma unroll
            for (int i = 0; i < 4; ++i) { kz[i] = *(const v4u*)(src + CK + i * 8); vz[i] = *(const v4u*)(src + CV + i * 8); } }
        else {
#pragma unroll
            for (int i = 0; i < 4; ++i) { kz[i] = (v4u){0u, 0u, 0u, 0u}; vz[i] = (v4u){0u, 0u, 0u, 0u}; } }
        float kf[32], vf[32];
#pragma unroll
        for (int i = 0; i < 4; ++i) { float t[8]; UNPACK8(kz[i], t);
#pragma unroll
            for (int e = 0; e < 8; ++e) kf[i * 8 + e] = t[e];
            UNPACK8(vz[i], t);
#pragma unroll
            for (int e = 0; e < 8; ++e) vf[i * 8 + e] = t[e]; }
        float ss = 0.f;
#pragma unroll
        for (int e = 0; e < 32; ++e) ss += kf[e] * kf[e];
        ss += __shfl_xor(ss, 1);
        const float rs = rsqrtf(ss * (1.0f / 64.0f) + EPS);
#pragma unroll
        for (int e = 0; e < 32; ++e) kf[e] = kf[e] * rs * kw[half * 32 + e];
#pragma unroll
        for (int i = 0; i < 4; ++i) { v4u o; o.x = pk2(kf[i * 8 + 0], kf[i * 8 + 1]); o.y = pk2(kf[i * 8 + 2], kf[i * 8 + 3]); o.z = pk2(kf[i * 8 + 4], kf[i * 8 + 5]); o.w = pk2(kf[i * 8 + 6], kf[i * 8 + 7]);
            *(LAS v4u*)(Ks + c * 72 + half * 32 + i * 8) = o; }
#pragma unroll
        for (int e = 0; e < 32; ++e) Vt[(half * 32 + e) * 280 + c] = (bf16)(__float_as_uint(vf[e]) >> 16);
        if (blk == 15 && c >= 128 && (h & 3) == 0) {
            float* dk = p.out + O_PK + ((size_t)(b * 128 + (c - 128)) * 4 + kvh) * 64 + half * 32;
            float* dv = p.out + O_PV + ((size_t)(b * 128 + (c - 128)) * 4 + kvh) * 64 + half * 32;
#pragma unroll
            for (int i = 0; i < 8; ++i) { *(f32x4*)(dk + i * 4) = (f32x4){kf[i * 4], kf[i * 4 + 1], kf[i * 4 + 2], kf[i * 4 + 3]}; *(f32x4*)(dv + i * 4) = (f32x4){vf[i * 4], vf[i * 4 + 1], vf[i * 4 + 2], vf[i * 4 + 3]}; }
        }
    }
    if (tid < 144) *(LAS v4u*)(Ks + 256 * 72 + tid * 8) = (v4u){0u, 0u, 0u, 0u};
    if (tid < 192) { const int d = tid / 3, j = tid % 3; *(LAS v4u*)(Vt + d * 280 + 256 + 8 * j) = (v4u){0u, 0u, 0u, 0u}; }
    {
        const int r = tid >> 2, qd = tid & 3;
        const bf16* src = PA + (size_t)(b * SEQ + blk * 128 + r) * NA + CQ + h * 64 + qd * 16;
        const v4u q0 = *(const v4u*)src, q1 = *(const v4u*)(src + 8);
        float qf[16]; { float t[8]; UNPACK8(q0, t);
#pragma unroll
            for (int e = 0; e < 8; ++e) qf[e] = t[e];
            UNPACK8(q1, t);
#pragma unroll
            for (int e = 0; e < 8; ++e) qf[8 + e] = t[e]; }
        float ss = 0.f;
#pragma unroll
        for (int e = 0; e < 16; ++e) ss += qf[e] * qf[e];
        ss += __shfl_xor(ss, 1); ss += __shfl_xor(ss, 2);
        const float rs = rsqrtf(ss * (1.0f / 64.0f) + EPS) * 0.125f;
#pragma unroll
        for (int e = 0; e < 16; ++e) qf[e] = qf[e] * rs * qw[qd * 16 + e];
        v4u o0, o1; o0.x = pk2(qf[0], qf[1]); o0.y = pk2(qf[2], qf[3]); o0.z = pk2(qf[4], qf[5]); o0.w = pk2(qf[6], qf[7]);
        o1.x = pk2(qf[8], qf[9]); o1.y = pk2(qf[10], qf[11]); o1.z = pk2(qf[12], qf[13]); o1.w = pk2(qf[14], qf[15]);
        *(LAS v4u*)(Qs + r * 72 + qd * 16) = o0; *(LAS v4u*)(Qs + r * 72 + qd * 16 + 8) = o1;
    }
    __syncthreads();
    bf16x8 aq[2];
#pragma unroll
    for (int ks = 0; ks < 2; ++ks) aq[ks] = *(LAS bf16x8*)(Qs + (16 * w + fr) * 72 + ks * 32 + fq * 8);
    f32x4 sc[10];
#pragma unroll
    for (int i = 0; i < 10; ++i) { sc[i] = (f32x4){0.f, 0.f, 0.f, 0.f};
#pragma unroll
        for (int ks = 0; ks < 2; ++ks) { const bf16x8 bk = *(LAS bf16x8*)(Ks + ((w + i) * 16 + fr) * 72 + ks * 32 + fq * 8); sc[i] = mfma16(aq[ks], bk, sc[i]); } }
    const float slope = exp2f(-0.5f * (float)(h + 1)), sink = p.in[13][h];
#pragma unroll
    for (int j = 0; j < 4; ++j) {
        const int r = 16 * w + fq * 4 + j;
        float mx = -INFINITY;
#pragma unroll
        for (int i = 0; i < 10; ++i) { const int c = (w + i) * 16 + fr, dist = 128 + r - c;
            const bool ok = dist >= 0 && dist <= 128 && c < 256 && (blk > 0 || c >= 128);
            const float v = ok ? sc[i][j] - slope * (float)dist : -INFINITY; sc[i][j] = v; mx = fmaxf(mx, v); }
        mx = fmaxf(mx, __shfl_xor(mx, 1)); mx = fmaxf(mx, __shfl_xor(mx, 2)); mx = fmaxf(mx, __shfl_xor(mx, 4)); mx = fmaxf(mx, __shfl_xor(mx, 8));
        mx = fmaxf(mx, sink);
        float sum = 0.f;
#pragma unroll
        for (int i = 0; i < 10; ++i) { const float e = __expf(sc[i][j] - mx); sc[i][j] = e; sum += e; }
        sum += __shfl_xor(sum, 1); sum += __shfl_xor(sum, 2); sum += __shfl_xor(sum, 4); sum += __shfl_xor(sum, 8);
        const float inv = 1.0f / (sum + __expf(sink - mx));
#pragma unroll
        for (int i = 0; i < 10; ++i) Ps[(fq * 4 + j) * 168 + i * 16 + fr] = (bf16)f2bf(sc[i][j] * inv);
    }
    asm volatile("s_waitcnt lgkmcnt(0)" ::: "memory");
    f32x4 o[4];
#pragma unroll
    for (int nt = 0; nt < 4; ++nt) o[nt] = (f32x4){0.f, 0.f, 0.f, 0.f};
#pragma unroll
    for (int ks = 0; ks < 5; ++ks) { const bf16x8 a = *(LAS bf16x8*)(Ps + fr * 168 + ks * 32 + fq * 8);
#pragma unroll
        for (int nt = 0; nt < 4; ++nt) { const bf16x8 bv = *(LAS bf16x8*)(Vt + (nt * 16 + fr) * 280 + w * 16 + ks * 32 + fq * 8); o[nt] = mfma16(a, bv, o[nt]); } }
#pragma unroll
    for (int j = 0; j < 4; ++j) { bf16* dst = AO + (size_t)(b * SEQ + blk * 128 + 16 * w + fq * 4 + j) * 1024 + h * 64 + fr;
#pragma unroll
        for (int nt = 0; nt < 4; ++nt) dst[nt * 16] = (bf16)f2bf(o[nt][j]); }
    __syncthreads();
}

__device__ __forceinline__ void mem_prompt_item(const KP& p, LAS unsigned char* lds, int item) {
    const int tid = threadIdx.x, lane = tid & 63, w = tid >> 6, fr = lane & 15, fq = lane >> 4;
    const int qt = item & 15, h = (item >> 4) & 3, b = item >> 6;
    LAS bf16* Qc = LDSP(bf16, 0);
    LAS bf16* Kc = LDSP(bf16, 18432);
    LAS bf16* Vt = LDSP(bf16, 0);
    LAS bf16* Ps = LDSP(bf16, 55296) + w * (16 * 264);
    LAS float* rq = LDSP(float, 122880); LAS float* rk = LDSP(float, 123392);
    const bf16* PA = (const bf16*)(p.ws + WS_BIG);
    const bf16* MKV = (const bf16*)(p.ws + WS_MKV);
    bf16* MO = (bf16*)(p.ws + WS_MO);
    const float* qw = p.in[22]; const float* kw = p.in[23];
    float ssq_q = 0.f, ssq_k = 0.f;
    f32x4 sc[16];
#pragma unroll
    for (int i = 0; i < 16; ++i) sc[i] = (f32x4){0.f, 0.f, 0.f, 0.f};
    for (int dc = 0; dc < 4; ++dc) {
        {   const int r = tid >> 2, qd = tid & 3;
            const bf16* src = PA + (size_t)(b * SEQ + qt * 128 + r) * NA + CQM + h * 256 + dc * 64 + qd * 16;
            const v4u q0 = *(const v4u*)src, q1 = *(const v4u*)(src + 8);
            float qf[16]; { float t[8]; UNPACK8(q0, t);
#pragma unroll
                for (int e = 0; e < 8; ++e) qf[e] = t[e];
                UNPACK8(q1, t);
#pragma unroll
                for (int e = 0; e < 8; ++e) qf[8 + e] = t[e]; }
#pragma unroll
            for (int e = 0; e < 16; ++e) { ssq_q += qf[e] * qf[e]; qf[e] *= qw[dc * 64 + qd * 16 + e]; }
            v4u o0, o1; o0.x = pk2(qf[0], qf[1]); o0.y = pk2(qf[2], qf[3]); o0.z = pk2(qf[4], qf[5]); o0.w = pk2(qf[6], qf[7]);
            o1.x = pk2(qf[8], qf[9]); o1.y = pk2(qf[10], qf[11]); o1.z = pk2(qf[12], qf[13]); o1.w = pk2(qf[14], qf[15]);
            *(LAS v4u*)(Qc + r * 72 + qd * 16) = o0; *(LAS v4u*)(Qc + r * 72 + qd * 16 + 8) = o1;
        }
        {   const int c = tid >> 1, half = tid & 1;
            const bf16* src = MKV + (size_t)(b * 256 + c) * 2048 + h * 256 + dc * 64 + half * 32;
#pragma unroll
            for (int i = 0; i < 4; ++i) { const v4u kz = *(const v4u*)(src + i * 8); float t[8]; UNPACK8(kz, t);
#pragma unroll
                for (int e = 0; e < 8; ++e) { ssq_k += t[e] * t[e]; t[e] *= kw[dc * 64 + half * 32 + i * 8 + e]; }
                v4u o; o.x = pk2(t[0], t[1]); o.y = pk2(t[2], t[3]); o.z = pk2(t[4], t[5]); o.w = pk2(t[6], t[7]);
                *(LAS v4u*)(Kc + c * 72 + half * 32 + i * 8) = o; }
        }
        __syncthreads();
        bf16x8 aq[2];
#pragma unroll
        for (int ks = 0; ks < 2; ++ks) aq[ks] = *(LAS bf16x8*)(Qc + (16 * w + fr) * 72 + ks * 32 + fq * 8);
#pragma unroll
        for (int i = 0; i < 16; ++i)
#pragma unroll
            for (int ks = 0; ks < 2; ++ks) { const bf16x8 bk = *(LAS bf16x8*)(Kc + (i * 16 + fr) * 72 + ks * 32 + fq * 8); sc[i] = mfma16(aq[ks], bk, sc[i]); }
        __syncthreads();
    }
    ssq_q += __shfl_xor(ssq_q, 1); ssq_q += __shfl_xor(ssq_q, 2); ssq_k += __shfl_xor(ssq_k, 1);
    if ((tid & 3) == 0) rq[tid >> 2] = rsqrtf(ssq_q * (1.0f / 256.0f) + EPS);
    if ((tid & 1) == 0) rk[tid >> 1] = rsqrtf(ssq_k * (1.0f / 256.0f) + EPS);
    __syncthreads();
    {
        float rkv[16];
#pragma unroll
        for (int i = 0; i < 16; ++i) rkv[i] = rk[i * 16 + fr];
#pragma unroll
        for (int j = 0; j < 4; ++j) {
            const float rqv = rq[16 * w + fq * 4 + j] * 0.0625f;
            float mx = -INFINITY;
#pragma unroll
            for (int i = 0; i < 16; ++i) { const float v = sc[i][j] * rqv * rkv[i]; sc[i][j] = v; mx = fmaxf(mx, v); }
            mx = fmaxf(mx, __shfl_xor(mx, 1)); mx = fmaxf(mx, __shfl_xor(mx, 2)); mx = fmaxf(mx, __shfl_xor(mx, 4)); mx = fmaxf(mx, __shfl_xor(mx, 8));
            float sum = 0.f;
#pragma unroll
            for (int i = 0; i < 16; ++i) { const float e = __expf(sc[i][j] - mx); sc[i][j] = e; sum += e; }
            sum += __shfl_xor(sum, 1); sum += __shfl_xor(sum, 2); sum += __shfl_xor(sum, 4); sum += __shfl_xor(sum, 8);
            const float inv = 1.0f / sum;
#pragma unroll
            for (int i = 0; i < 16; ++i) Ps[(fq * 4 + j) * 264 + i * 16 + fr] = (bf16)f2bf(sc[i][j] * inv);
        }
    }
    if (qt == 0) {
        for (int idx = tid; idx < 256 * 32; idx += 512) { const int c = idx >> 5, ch = idx & 31;
            const v4u kz = *(const v4u*)(MKV + (size_t)(b * 256 + c) * 2048 + h * 256 + ch * 8); float t[8]; UNPACK8(kz, t);
            const float r = rk[c];
            float* d = p.out + O_PMK + ((size_t)(b * 256 + c) * 4 + h) * 256 + ch * 8;
            *(f32x4*)d = (f32x4){t[0] * r * kw[ch * 8], t[1] * r * kw[ch * 8 + 1], t[2] * r * kw[ch * 8 + 2], t[3] * r * kw[ch * 8 + 3]};
            *(f32x4*)(d + 4) = (f32x4){t[4] * r * kw[ch * 8 + 4], t[5] * r * kw[ch * 8 + 5], t[6] * r * kw[ch * 8 + 6], t[7] * r * kw[ch * 8 + 7]}; }
    }
    for (int dc = 0; dc < 4; ++dc) {
        {   const int c = tid >> 1, half = tid & 1;
            const bf16* src = MKV + (size_t)(b * 256 + c) * 2048 + 1024 + h * 256 + dc * 64 + half * 32;
#pragma unroll
            for (int i = 0; i < 4; ++i) { const v4u vz = *(const v4u*)(src + i * 8);
                Vt[(half * 32 + i * 8 + 0) * 264 + c] = (bf16)(vz.x & 0xffffu); Vt[(half * 32 + i * 8 + 1) * 264 + c] = (bf16)(vz.x >> 16);
                Vt[(half * 32 + i * 8 + 2) * 264 + c] = (bf16)(vz.y & 0xffffu); Vt[(half * 32 + i * 8 + 3) * 264 + c] = (bf16)(vz.y >> 16);
                Vt[(half * 32 + i * 8 + 4) * 264 + c] = (bf16)(vz.z & 0xffffu); Vt[(half * 32 + i * 8 + 5) * 264 + c] = (bf16)(vz.z >> 16);
                Vt[(half * 32 + i * 8 + 6) * 264 + c] = (bf16)(vz.w & 0xffffu); Vt[(half * 32 + i * 8 + 7) * 264 + c] = (bf16)(vz.w >> 16); }
        }
        __syncthreads();
        f32x4 o[4];
#pragma unroll
        for (int nt = 0; nt < 4; ++nt) o[nt] = (f32x4){0.f, 0.f, 0.f, 0.f};
#pragma unroll
        for (int ks = 0; ks < 8; ++ks) { const bf16x8 a = *(LAS bf16x8*)(Ps + fr * 264 + ks * 32 + fq * 8);
#pragma unroll
            for (int nt = 0; nt < 4; ++nt) { const bf16x8 bv = *(LAS bf16x8*)(Vt + (nt * 16 + fr) * 264 + ks * 32 + fq * 8); o[nt] = mfma16(a, bv, o[nt]); } }
#pragma unroll
        for (int j = 0; j < 4; ++j) { bf16* dst = MO + (size_t)(b * SEQ + qt * 128 + 16 * w + fq * 4 + j) * 1024 + h * 256 + dc * 64 + fr;
#pragma unroll
            for (int nt = 0; nt < 4; ++nt) dst[nt * 16] = (bf16)f2bf(o[nt][j]); }
        __syncthreads();
    }
}

__device__ __forceinline__ float softplusf_(float x) { return x > 20.f ? x : log1pf(__expf(x)); }
__device__ __forceinline__ void ssd_prompt_item(const KP& p, LAS unsigned char* lds, int item) {
    const int tid = threadIdx.x, lane = tid & 63, w = tid >> 6, fr = lane & 15, fq = lane >> 4;
    const int head = item & 31, b = item >> 5, g = head >> 3;
    LAS bf16* Xt = LDSP(bf16, 0);
    LAS bf16* Bs = LDSP(bf16, 17408);
    LAS bf16* Cs = LDSP(bf16, 52224);
    LAS bf16* Ws = LDSP(bf16, 87040) + w * (16 * 136);
    LAS bf16* Hs = LDSP(bf16, 121856);
    LAS float* dtv = LDSP(float, 139264); LAS float* acs = LDSP(float, 139776); LAS float* das = LDSP(float, 140288);
    const bf16* PA = (const bf16*)(p.ws + WS_BIG);
    const float* DT = (const float*)(p.ws + WS_DT);
    float* SSQ = (float*)(p.ws + WS_SSQ);
    bf16* SO = (bf16*)((unsigned char*)(p.out + O_YP) + YP_SO);
    const float dtb = p.in[16][head], Aneg = -__expf(p.in[17][head]), Dh = p.in[18][head];
    const int cgp = tid % 40, tr = tid / 40;
    const int ch0 = cgp < 8 ? head * 64 + cgp * 8 : (cgp < 24 ? 2048 + g * 128 + (cgp - 8) * 8 : 2560 + g * 128 + (cgp - 24) * 8);
    float cw0[8], cw1[8], cw2[8], cw3[8], cbv[8];
    if (tid < 320) {
#pragma unroll
        for (int e = 0; e < 8; ++e) { cw0[e] = p.in[14][0 * CONVCH + ch0 + e]; cw1[e] = p.in[14][1 * CONVCH + ch0 + e]; cw2[e] = p.in[14][2 * CONVCH + ch0 + e]; cw3[e] = p.in[14][3 * CONVCH + ch0 + e]; cbv[e] = p.in[15][ch0 + e]; }
    }
    f32x4 hst[4];
#pragma unroll
    for (int i = 0; i < 4; ++i) hst[i] = (f32x4){0.f, 0.f, 0.f, 0.f};
    const int pt = w & 3, nb0 = (w >> 2) * 4;
    for (int c = 0; c < 16; ++c) {
        const int t0 = c * 128;
        if (tid < 320) {
            const int l0 = tr * 16;
            const bf16* src = PA + (size_t)(b * SEQ) * NA + CXBC + ch0;
            float r0[8], r1[8], r2[8];
            {   const int ta = t0 + l0 - 3;
                v4u z0 = {0u, 0u, 0u, 0u}, z1 = z0, z2 = z0;
                if (ta >= 0) z0 = *(const v4u*)(src + (size_t)ta * NA);
                if (ta + 1 >= 0) z1 = *(const v4u*)(src + (size_t)(ta + 1) * NA);
                if (ta + 2 >= 0) z2 = *(const v4u*)(src + (size_t)(ta + 2) * NA);
                UNPACK8(z0, r0); UNPACK8(z1, r1); UNPACK8(z2, r2); }
#pragma unroll 4
            for (int l = 0; l < 16; ++l) {
                const v4u zc = *(const v4u*)(src + (size_t)(t0 + l0 + l) * NA);
                float cur[8], ov[8]; UNPACK8(zc, cur);
#pragma unroll
                for (int e = 0; e < 8; ++e) { const float v = cw0[e] * r0[e] + cw1[e] * r1[e] + cw2[e] * r2[e] + cw3[e] * cur[e] + cbv[e]; ov[e] = siluf_(v); r0[e] = r1[e]; r1[e] = r2[e]; r2[e] = cur[e]; }
                if (cgp < 8) {
#pragma unroll
                    for (int e = 0; e < 8; ++e) Xt[(cgp * 8 + e) * 136 + l0 + l] = (bf16)f2bf(ov[e]);
                } else {
                    v4u o; o.x = pk2(ov[0], ov[1]); o.y = pk2(ov[2], ov[3]); o.z = pk2(ov[4], ov[5]); o.w = pk2(ov[6], ov[7]);
                    if (cgp < 24) *(LAS v4u*)(Bs + (l0 + l) * 136 + (cgp - 8) * 8) = o; else *(LAS v4u*)(Cs + (l0 + l) * 136 + (cgp - 24) * 8) = o;
                }
            }
        } else if (tid < 448) {
            const int l = tid - 320;
            const float dt = softplusf_(DT[(size_t)(b * SEQ + t0 + l) * 32 + head] + dtb);
            dtv[l] = dt; das[l] = dt * Aneg;
        }
#pragma unroll
        for (int i = 0; i < 4; ++i)
#pragma unroll
            for (int j = 0; j < 4; ++j) Hs[(pt * 16 + fq * 4 + j) * 136 + (nb0 + i) * 16 + fr] = (bf16)f2bf(hst[i][j]);
        __syncthreads();
        if (w == 0) { const float a0 = das[2 * lane], a1 = das[2 * lane + 1]; float s = a0 + a1;
#pragma unroll
            for (int off = 1; off < 64; off <<= 1) { const float t = __shfl_up(s, off); if (lane >= off) s += t; }
            acs[2 * lane + 1] = s; acs[2 * lane] = s - a1; }
        __syncthreads();
        bf16x8 ac[4];
#pragma unroll
        for (int ks = 0; ks < 4; ++ks) ac[ks] = *(LAS bf16x8*)(Cs + (16 * w + fr) * 136 + ks * 32 + fq * 8);
        f32x4 yo[4], yd[4];
#pragma unroll
        for (int nt = 0; nt < 4; ++nt) { yo[nt] = (f32x4){0.f, 0.f, 0.f, 0.f}; yd[nt] = (f32x4){0.f, 0.f, 0.f, 0.f};
#pragma unroll
            for (int ks = 0; ks < 4; ++ks) { const bf16x8 bh = *(LAS bf16x8*)(Hs + (nt * 16 + fr) * 136 + ks * 32 + fq * 8); yo[nt] = mfma16(ac[ks], bh, yo[nt]); } }
        float al[4];
#pragma unroll
        for (int j = 0; j < 4; ++j) al[j] = acs[16 * w + fq * 4 + j];
#pragma unroll
        for (int nt = 0; nt < 8; ++nt) {
            if (nt <= w) {
                f32x4 cb = {0.f, 0.f, 0.f, 0.f};
#pragma unroll
                for (int ks = 0; ks < 4; ++ks) { const bf16x8 bb = *(LAS bf16x8*)(Bs + (nt * 16 + fr) * 136 + ks * 32 + fq * 8); cb = mfma16(ac[ks], bb, cb); }
                const int s = nt * 16 + fr; const float as_ = acs[s], dts = dtv[s];
#pragma unroll
                for (int j = 0; j < 4; ++j) { const int l = 16 * w + fq * 4 + j; const float wv = (s <= l) ? cb[j] * __expf(al[j] - as_) * dts : 0.f; Ws[(fq * 4 + j) * 136 + s] = (bf16)f2bf(wv); }
            } else {
#pragma unroll
                for (int j = 0; j < 4; ++j) Ws[(fq * 4 + j) * 136 + nt * 16 + fr] = (bf16)0;
            }
        }
        asm volatile("s_waitcnt lgkmcnt(0)" ::: "memory");
#pragma unroll
        for (int ks = 0; ks < 4; ++ks) {
            if (2 * ks <= w) { const bf16x8 aw = *(LAS bf16x8*)(Ws + fr * 136 + ks * 32 + fq * 8);
#pragma unroll
                for (int nt = 0; nt < 4; ++nt) { const bf16x8 bx = *(LAS bf16x8*)(Xt + (nt * 16 + fr) * 136 + ks * 32 + fq * 8); yd[nt] = mfma16(aw, bx, yd[nt]); } }
        }
#pragma unroll
        for (int j = 0; j < 4; ++j) {
            const int l = 16 * w + fq * 4 + j; const size_t tok = (size_t)(b * SEQ + t0 + l); const float el = __expf(al[j]);
            float ss = 0.f;
#pragma unroll
            for (int nt = 0; nt < 4; ++nt) { const int pp = nt * 16 + fr; const float xv = bf2f(Xt[pp * 136 + l]);
                const float y = yd[nt][j] + el * yo[nt][j] + Dh * xv;
                const float zv = bf2f(PA[tok * NA + CZ + head * 64 + pp]);
                const float yz = y * siluf_(zv); ss += yz * yz; SO[tok * 2048 + head * 64 + pp] = (bf16)f2bf(yz); }
            ss += __shfl_xor(ss, 1); ss += __shfl_xor(ss, 2); ss += __shfl_xor(ss, 4); ss += __shfl_xor(ss, 8);
            if (fr == 0) SSQ[tok * 32 + head] = ss;
        }
        const float aL = acs[127];
        f32x4 st[4];
#pragma unroll
        for (int i = 0; i < 4; ++i) st[i] = (f32x4){0.f, 0.f, 0.f, 0.f};
#pragma unroll
        for (int ks = 0; ks < 4; ++ks) {
            const bf16x8 ax = *(LAS bf16x8*)(Xt + (pt * 16 + fr) * 136 + ks * 32 + fq * 8);
            float coef[8];
#pragma unroll
            for (int e = 0; e < 8; ++e) { const int l = ks * 32 + fq * 8 + e; coef[e] = __expf(aL - acs[l]) * dtv[l]; }
#pragma unroll
            for (int i = 0; i < 4; ++i) { const int n = (nb0 + i) * 16 + fr;
                float v[8];
#pragma unroll
                for (int e = 0; e < 8; ++e) v[e] = bf2f(Bs[(ks * 32 + fq * 8 + e) * 136 + n]) * coef[e];
                v4u pw; pw.x = pk2(v[0], v[1]); pw.y = pk2(v[2], v[3]); pw.z = pk2(v[4], v[5]); pw.w = pk2(v[6], v[7]);
                const bf16x8 bb = __builtin_bit_cast(bf16x8, pw);
                st[i] = mfma16(ax, bb, st[i]); }
        }
        const float eL = __expf(aL);
#pragma unroll
        for (int i = 0; i < 4; ++i) hst[i] = hst[i] * eL + st[i];
        __syncthreads();
    }
#pragma unroll
    for (int i = 0; i < 4; ++i)
#pragma unroll
        for (int j = 0; j < 4; ++j) p.out[O_PSSM + ((size_t)(b * 32 + head) * 64 + pt * 16 + fq * 4 + j) * 128 + (nb0 + i) * 16 + fr] = hst[i][j];
    if (tid < 24) { const int j = tid >> 3, cc = tid & 7; const v4u z = *(const v4u*)(PA + (size_t)(b * SEQ + SEQ - 3 + j) * NA + CXBC + head * 64 + cc * 8); float t[8]; UNPACK8(z, t);
        float* d = p.out + O_PCONV + (size_t)(b * 3 + j) * CONVCH + head * 64 + cc * 8; *(f32x4*)d = (f32x4){t[0], t[1], t[2], t[3]}; *(f32x4*)(d + 4) = (f32x4){t[4], t[5], t[6], t[7]}; }
    if ((head & 7) == 0 && tid >= 32 && tid < 128) { const int idx = tid - 32, j = idx >> 5, cc = idx & 31;
        const int ch = cc < 16 ? 2048 + g * 128 + cc * 8 : 2560 + g * 128 + (cc - 16) * 8;
        const v4u z = *(const v4u*)(PA + (size_t)(b * SEQ + SEQ - 3 + j) * NA + CXBC + ch); float t[8]; UNPACK8(z, t);
        float* d = p.out + O_PCONV + (size_t)(b * 3 + j) * CONVCH + ch; *(f32x4*)d = (f32x4){t[0], t[1], t[2], t[3]}; *(f32x4*)(d + 4) = (f32x4){t[4], t[5], t[6], t[7]}; }
}

__device__ __forceinline__ void ssd_decode_item(const KP& p, LAS unsigned char* lds, int item) {
    const int tid = threadIdx.x, lane = tid & 63;
    const int head = item & 31, b = item >> 5, g = head >> 3;
    const size_t tok = (size_t)(MP + b);
    LAS float* xs = LDSP(float, 0); LAS float* Bv = LDSP(float, 256); LAS float* Cv = LDSP(float, 768); LAS float* red = LDSP(float, 1280);
    const bf16* PA = (const bf16*)(p.ws + WS_BIG);
    const float* DT = (const float*)(p.ws + WS_DT);
    float* SSQ = (float*)(p.ws + WS_SSQ);
    bf16* SO = (bf16*)((unsigned char*)(p.out + O_YP) + YP_SO);
    if (tid < 320) {
        const int ch = tid < 64 ? head * 64 + tid : (tid < 192 ? 2048 + g * 128 + (tid - 64) : 2560 + g * 128 + (tid - 192));
        const float raw = bf2f(PA[tok * NA + CXBC + ch]);
        const float s0 = p.in[7][(size_t)(b * 3 + 0) * CONVCH + ch], s1 = p.in[7][(size_t)(b * 3 + 1) * CONVCH + ch], s2 = p.in[7][(size_t)(b * 3 + 2) * CONVCH + ch];
        const float v = p.in[14][ch] * s0 + p.in[14][CONVCH + ch] * s1 + p.in[14][2 * CONVCH + ch] * s2 + p.in[14][3 * CONVCH + ch] * raw + p.in[15][ch];
        const float o = siluf_(v);
        if (tid < 64) xs[tid] = o; else if (tid < 192) Bv[tid - 64] = o; else Cv[tid - 192] = o;
        if (tid < 64 || (head & 7) == 0) { float* d = p.out + O_SCONV + (size_t)(b * 3) * CONVCH + ch; d[0] = s1; d[CONVCH] = s2; d[2 * CONVCH] = raw; }
    }
    __syncthreads();
    const float dt = softplusf_(DT[tok * 32 + head] + p.in[16][head]);
    const float dA = __expf(dt * (-__expf(p.in[17][head]))), Dh = p.in[18][head];
    const int pp = tid >> 3, q = tid & 7;
    const float xv = xs[pp], xdt = xv * dt;
    const size_t hoff = ((size_t)(b * 32 + head) * 64 + pp) * 128;
    float part = 0.f, cbp = 0.f;
#pragma unroll
    for (int i = 0; i < 4; ++i) {
        const int n = q * 4 + 32 * i;
        const f32x4 hv = *(const f32x4*)(p.in[6] + hoff + n);
        const f32x4 bv = {Bv[n], Bv[n + 1], Bv[n + 2], Bv[n + 3]}, cv = {Cv[n], Cv[n + 1], Cv[n + 2], Cv[n + 3]};
        part += (cv[0] * hv[0] + cv[1] * hv[1]) + (cv[2] * hv[2] + cv[3] * hv[3]);
        cbp += (cv[0] * bv[0] + cv[1] * bv[1]) + (cv[2] * bv[2] + cv[3] * bv[3]);
        *(f32x4*)(p.out + O_SSSM + hoff + n) = hv * dA + bv * xdt;
    }
    part += __shfl_xor(part, 1); part += __shfl_xor(part, 2); part += __shfl_xor(part, 4);
    cbp += __shfl_xor(cbp, 1); cbp += __shfl_xor(cbp, 2); cbp += __shfl_xor(cbp, 4);
    if (q == 0) {
        const float y = cbp * dt * xv + part * dA + Dh * xv;
        const float zv = bf2f(PA[tok * NA + CZ + head * 64 + pp]);
        const float yz = y * siluf_(zv);
        SO[tok * 2048 + head * 64 + pp] = (bf16)f2bf(yz);
        red[pp] = yz * yz;
    }
    __syncthreads();
    if (tid < 64) { const float s = wave_sum(red[lane]); if (lane == 0) SSQ[tok * 32 + head] = s; }
    __syncthreads();
}

__device__ __forceinline__ void swa_decode_item(const KP& p, LAS unsigned char* lds, int item) {
    const int tid = threadIdx.x, lane = tid & 63, w = tid >> 6;
    const int kvh = item & 3, b = item >> 2;
    const size_t tok = (size_t)(MP + b);
    LAS float* Kf = LDSP(float, 0);
    LAS float* Vf = LDSP(float, 33792);
    LAS float* qn = LDSP(float, 66816);
    LAS float* sc = LDSP(float, 67840);
    const bf16* PA = (const bf16*)(p.ws + WS_BIG);
    bf16* AO = (bf16*)((unsigned char*)(p.out + O_YP) + YP_AO);
    for (int idx = tid; idx < 128 * 16; idx += 512) { const int j = idx >> 4, c4 = idx & 15;
        const size_t off = ((size_t)(b * 128 + j) * 4 + kvh) * 64 + c4 * 4;
        const f32x4 kv = *(const f32x4*)(p.in[2] + off), vv = *(const f32x4*)(p.in[3] + off);
        Kf[j * 65 + c4 * 4 + 0] = kv[0]; Kf[j * 65 + c4 * 4 + 1] = kv[1]; Kf[j * 65 + c4 * 4 + 2] = kv[2]; Kf[j * 65 + c4 * 4 + 3] = kv[3];
        *(LAS f32x4*)(Vf + j * 64 + c4 * 4) = vv;
        if (j >= 1) { const size_t o2 = ((size_t)(b * 128 + j - 1) * 4 + kvh) * 64 + c4 * 4; *(f32x4*)(p.out + O_SK + o2) = kv; *(f32x4*)(p.out + O_SV + o2) = vv; } }
    if (w == 0) { const float kr = bf2f(PA[tok * NA + CK + kvh * 64 + lane]); const float ss = wave_sum(kr * kr);
        const float kn = kr * rsqrtf(ss * (1.0f / 64.0f) + EPS) * p.in[12][lane];
        Kf[128 * 65 + lane] = kn; p.out[O_SK + ((size_t)(b * 128 + 127) * 4 + kvh) * 64 + lane] = kn; }
    else if (w == 1) { const float vr = bf2f(PA[tok * NA + CV + kvh * 64 + lane]); Vf[128 * 64 + lane] = vr; p.out[O_SV + ((size_t)(b * 128 + 127) * 4 + kvh) * 64 + lane] = vr; }
    else if (w < 6) { const int hq = w - 2; const float qr = bf2f(PA[tok * NA + CQ + (kvh * 4 + hq) * 64 + lane]); const float ss = wave_sum(qr * qr);
        qn[hq * 64 + lane] = qr * rsqrtf(ss * (1.0f / 64.0f) + EPS) * p.in[11][lane] * 0.125f; }
    __syncthreads();
    for (int idx = tid; idx < 4 * 129; idx += 512) { const int hq = idx / 129, j = idx % 129;
        float d = 0.f;
#pragma unroll 8
        for (int e = 0; e < 64; ++e) d += qn[hq * 64 + e] * Kf[j * 65 + e];
        const float slope = exp2f(-0.5f * (float)(kvh * 4 + hq + 1));
        sc[hq * 132 + j] = d - slope * (float)(128 - j); }
    __syncthreads();
    if (w < 4) { const int hq = w; const float sink = p.in[13][kvh * 4 + hq];
        const float v0 = sc[hq * 132 + lane], v1 = sc[hq * 132 + 64 + lane], v2 = lane == 0 ? sc[hq * 132 + 128] : -INFINITY;
        const float mx = fmaxf(wave_max(fmaxf(fmaxf(v0, v1), v2)), sink);
        const float e0 = __expf(v0 - mx), e1 = __expf(v1 - mx), e2 = lane == 0 ? __expf(v2 - mx) : 0.f;
        const float inv = 1.0f / (wave_sum(e0 + e1 + e2) + __expf(sink - mx));
        sc[hq * 132 + lane] = e0 * inv; sc[hq * 132 + 64 + lane] = e1 * inv; if (lane == 0) sc[hq * 132 + 128] = e2 * inv; }
    __syncthreads();
    if (tid < 256) { const int hq = w; float o = 0.f;
#pragma unroll 4
        for (int j = 0; j < 129; ++j) o += sc[hq * 132 + j] * Vf[j * 64 + lane];
        AO[tok * 1024 + (kvh * 4 + hq) * 64 + lane] = (bf16)f2bf(o); }
    __syncthreads();
}

__device__ __forceinline__ void mem_decode_item(const KP& p, LAS unsigned char* lds, int item) {
    const int tid = threadIdx.x, lane = tid & 63, w = tid >> 6;
    const int h = item & 3, b = item >> 2;
    const size_t tok = (size_t)(MP + b);
    LAS float* sc = LDSP(float, 0); LAS float* part = LDSP(float, 1024);
    const bf16* PA = (const bf16*)(p.ws + WS_BIG);
    bf16* MO = (bf16*)(p.ws + WS_MO);
    float q[4];
    {   const v2u qz = *(const v2u*)(PA + tok * NA + CQM + h * 256 + lane * 4);
        q[0] = lo16(qz.x); q[1] = hi16(qz.x); q[2] = lo16(qz.y); q[3] = hi16(qz.y);
        const float ss = wave_sum((q[0] * q[0] + q[1] * q[1]) + (q[2] * q[2] + q[3] * q[3]));
        const float rs = rsqrtf(ss * (1.0f / 256.0f) + EPS) * 0.0625f;
        const f32x4 wq = *(const f32x4*)(p.in[22] + lane * 4);
        q[0] *= rs * wq[0]; q[1] *= rs * wq[1]; q[2] *= rs * wq[2]; q[3] *= rs * wq[3]; }
    const float* Kb = p.in[4] + ((size_t)(b * 256) * 4 + h) * 256;
    const float* Vb = p.in[5] + ((size_t)(b * 256) * 4 + h) * 256;
#pragma unroll 4
    for (int i = 0; i < 32; ++i) { const int m = w + 8 * i;
        const f32x4 kv = *(const f32x4*)(Kb + (size_t)m * 1024 + lane * 4);
        const float d = wave_sum((q[0] * kv[0] + q[1] * kv[1]) + (q[2] * kv[2] + q[3] * kv[3]));
        if (lane == 0) sc[m] = d; }
    __syncthreads();
    if (w == 0) { const f32x4 v = *(LAS f32x4*)(sc + lane * 4);
        const float mx = wave_max(fmaxf(fmaxf(v[0], v[1]), fmaxf(v[2], v[3])));
        const float e0 = __expf(v[0] - mx), e1 = __expf(v[1] - mx), e2 = __expf(v[2] - mx), e3 = __expf(v[3] - mx);
        const float inv = 1.0f / wave_sum((e0 + e1) + (e2 + e3));
        *(LAS f32x4*)(sc + lane * 4) = (f32x4){e0 * inv, e1 * inv, e2 * inv, e3 * inv}; }
    __syncthreads();
    {   const int half = tid >> 8, d = tid & 255; float o = 0.f;
#pragma unroll 8
        for (int m = half * 128; m < half * 128 + 128; ++m) o += sc[m] * Vb[(size_t)m * 1024 + d];
        part[half * 256 + d] = o; }
    __syncthreads();
    if (tid < 256) MO[tok * 1024 + h * 256 + tid] = (bf16)f2bf(part[tid] + part[256 + tid]);
    __syncthreads();
}

__device__ __forceinline__ void ssd_norm_pass(const KP& p) {
    const int tid = threadIdx.x, lane = tid & 63, wave = tid >> 6;
    const int gw = blockIdx.x * 8 + wave, NGW = gridDim.x * 8;
    const float* SSQ = (const float*)(p.ws + WS_SSQ);
    bf16* SO = (bf16*)((unsigned char*)(p.out + O_YP) + YP_SO);
    for (int r = gw; r < MTOK; r += NGW) {
#pragma unroll
        for (int it = 0; it < 4; ++it) {
            const f32x4 a = *(const f32x4*)(SSQ + (size_t)r * 32 + it * 8), c = *(const f32x4*)(SSQ + (size_t)r * 32 + it * 8 + 4);
            const float rs = rsqrtf(((a[0] + a[1]) + (a[2] + a[3]) + (c[0] + c[1]) + (c[2] + c[3])) * (1.0f / 512.0f) + EPS);
            v4u* ptr = (v4u*)(SO + (size_t)r * 2048 + it * 512 + lane * 8);
            const v4u z = *ptr; float t[8]; UNPACK8(z, t);
            v4u o; o.x = pk2(t[0] * rs, t[1] * rs); o.y = pk2(t[2] * rs, t[3] * rs); o.z = pk2(t[4] * rs, t[5] * rs); o.w = pk2(t[6] * rs, t[7] * rs);
            *ptr = o;
        }
    }
    bf16* AO = (bf16*)((unsigned char*)(p.out + O_YP) + YP_AO); bf16* MO = (bf16*)(p.ws + WS_MO);
    const v4u zero = {0u, 0u, 0u, 0u};
    for (int i = blockIdx.x * 512 + tid; i < (MPAD - MTOK) * 256; i += gridDim.x * 512) *((v4u*)(SO + (size_t)MTOK * 2048) + i) = zero;
    for (int i = blockIdx.x * 512 + tid; i < (MPAD - MTOK) * 128; i += gridDim.x * 512) { *((v4u*)(AO + (size_t)MTOK * 1024) + i) = zero; *((v4u*)(MO + (size_t)MTOK * 1024) + i) = zero; }
}


#ifndef NO_SSDP
#define ITEM_SSDP ssd_prompt_item(p, lds, it);
#else
#define ITEM_SSDP
#endif
#ifndef NO_MEMP
#define ITEM_MEMP mem_prompt_item(p, lds, it);
#else
#define ITEM_MEMP
#endif
#ifndef NO_SWAP
#define ITEM_SWAP swa_prompt_item(p, lds, it);
#else
#define ITEM_SWAP
#endif
#ifndef NO_SSDD
#define ITEM_SSDD ssd_decode_item(p, lds, it);
#else
#define ITEM_SSDD
#endif
#ifndef NO_MEMD
#define ITEM_MEMD mem_decode_item(p, lds, it);
#else
#define ITEM_MEMD
#endif
#ifndef NO_SWAD
#define ITEM_SWAD swa_decode_item(p, lds, it);
#else
#define ITEM_SWAD
#endif
#define GEMM(EpiT, Eobj, Aptr, Bptr, M_, N_, K_, cid) do { pg8::Gemm g_{(const pg8::bf16_t*)(Aptr), (const pg8::bf16_t*)(Bptr), M_, N_, K_}; pg8::StaticOrder S_; S_.init(M_, N_, (int)gridDim.x, (cid)); \
    pg8::gemm_phase<EpiT, pg8::StaticOrder, PG8_ALIGN, PG8_SP2>(lds, g_, S_, Eobj); } while (0)

__global__ void __launch_bounds__(512, 2) mega(KP p) {
    extern __shared__ __attribute__((aligned(16))) unsigned char lds_raw[];
    LAS unsigned char* lds = (LAS unsigned char*)lds_raw;
    cg::grid_group grid = cg::this_grid();
    unsigned char* ws = p.ws;
    const int lo = p.ph_lo, hi = p.ph_hi;
#define IN(k) (lo <= (k) && (k) < hi)
#define SEAM(k) do { if (IN(k) && IN((k) + 1)) grid.sync(); } while (0)
    bf16* XB = (bf16*)(ws + WS_XB); bf16* MG = XB;
    bf16* PA = (bf16*)(ws + WS_BIG); bf16* GATES = PA; bf16* ACT = (bf16*)(ws + WS_BIG + BIG_ACT); bf16* X1B = (bf16*)(ws + WS_BIG + BIG_X1B);
    bf16* AO = (bf16*)((unsigned char*)(p.out + O_YP) + YP_AO); bf16* SO = (bf16*)((unsigned char*)(p.out + O_YP) + YP_SO); bf16* MO = (bf16*)(ws + WS_MO);
    float* RS1 = (float*)(ws + WS_RS1); float* RSM = (float*)(ws + WS_RSM); float* PART = (float*)(ws + WS_PART);
    const int bid = (int)blockIdx.x;

    if (IN(0)) { prologue(p, lds); __syncthreads(); }
    SEAM(0);
    if (IN(1)) {
        EpiProj<0> E1{PA, NA, RS1, (float*)(ws + WS_DT), CDT, 32, 32};
        GEMM(EpiProj<0>, E1, XB, ws + WS_WIN, MPAD, NA, 2048, bid);
        EpiProj<0> E2{(bf16*)(ws + WS_MKV), 2048, RSM, p.out + O_PMV, 1024, 1024, 1024};
        GEMM(EpiProj<0>, E2, ws + WS_MB, ws + WS_WM, 4096, 2048, 2048, (int)gridDim.x - 1 - bid);
    }
    SEAM(1);
    if (IN(2)) {
        const int G_ = (int)gridDim.x;
        for (int it = bid; it < 512; it += G_) { ITEM_SSDP }
        for (int it = bid; it < 1024; it += G_) { ITEM_MEMP }
        for (int it = bid; it < 4096; it += G_) { ITEM_SWAP }
        for (int it = bid; it < 4096; it += G_) { ITEM_SSDD }
        for (int it = bid; it < 512; it += G_) { ITEM_MEMD }
        for (int it = bid; it < 512; it += G_) { ITEM_SWAD }
    }
    SEAM(2);
    if (IN(3)) {
        ssd_norm_pass(p);
        __syncthreads();
        EpiProj<1> E{GATES, NG, RS1, nullptr, 0, 0, 0};
        GEMM(EpiProj<1>, E, XB, ws + WS_WIN + (size_t)NA * 2048 * 2, MPAD, NG, 2048, bid);
    }
    SEAM(3);
    if (IN(4)) {
        EpiMerge<0> Ea{MG, GATES};
        GEMM(EpiMerge<0>, Ea, AO, ws + WS_WSWA, MPAD, 2048, 1024, bid);
        EpiMerge<1> Eb{MG, GATES + 4096};
        GEMM(EpiMerge<1>, Eb, MO, ws + WS_WMEM, MPAD, 2048, 1024, bid);
        EpiMerge<1> Ec{MG, GATES + 2048};
        GEMM(EpiMerge<1>, Ec, SO, ws + WS_WSSD, MPAD, 2048, 2048, bid);
    }
    SEAM(4);
    if (IN(5)) {
        EpiWout E{p.in[0], p.in[1], p.out + O_YP, p.out + O_YS, X1B, PART};
        GEMM(EpiWout, E, MG, ws + WS_WOUT, MPAD, 2048, 2048, bid);
    }
    SEAM(5);
    if (IN(6)) {
        EpiFfnUp E{PART, ACT};
        GEMM(EpiFfnUp, E, X1B, ws + WS_WGU, MPAD, 2 * DFF, 2048, bid);
    }
    SEAM(6);
    if (IN(7)) {
        EpiDown E{p.out + O_YP, p.out + O_YS};
        GEMM(EpiDown, E, ACT, ws + WS_WD, MPAD, 2048, DFF, bid);
    }
#undef IN
#undef SEAM
}

#ifndef N_LAUNCHES
#define N_LAUNCHES 1
#endif
extern "C" void kernel_launch(void* const* d_in, const int* in_sizes, int n_in, void* d_out, int out_size, void* d_ws, size_t ws_size, hipStream_t stream) {
    static int grid = 0;
    if (grid == 0) {
        if (n_in != 32 || (size_t)out_size != O_END || ws_size < WS_END) { fprintf(stderr, "kernel_launch: unexpected sizes n_in %d out %d ws %zu (need %zu)\n", n_in, out_size, ws_size, (size_t)WS_END); grid = -1; return; }
        int dev = 0, cus = 0, per_cu = 0;
        hipGetDevice(&dev); hipDeviceGetAttribute(&cus, hipDeviceAttributeMultiprocessorCount, dev);
        if (hipFuncSetAttribute((const void*)mega, hipFuncAttributeMaxDynamicSharedMemorySize, LDS_BYTES) != hipSuccess) { fprintf(stderr, "kernel_launch: hipFuncSetAttribute failed\n"); grid = -1; return; }
        if (hipOccupancyMaxActiveBlocksPerMultiprocessor(&per_cu, (const void*)mega, 512, LDS_BYTES) != hipSuccess || per_cu < 1) { fprintf(stderr, "kernel_launch: occupancy query says %d\n", per_cu); per_cu = 1; }
        (void)hipGetLastError();
        grid = cus;
    }
    if (grid < 0) return;
    KP p{};
    for (int i = 0; i < 32; ++i) p.in[i] = (const float*)d_in[i];
    p.out = (float*)d_out; p.ws = (unsigned char*)d_ws;
#if N_LAUNCHES == 1
    p.ph_lo = 0; p.ph_hi = 8;
    void* args[] = {&p};
    hipError_t e = hipLaunchCooperativeKernel((const void*)mega, dim3(grid), dim3(512), args, LDS_BYTES, stream);
    if (e != hipSuccess) fprintf(stderr, "cooperative launch failed: %s (grid %d)\n", hipGetErrorString(e), grid);
#else
    for (int k = 0; k < 8; ++k) { p.ph_lo = k; p.ph_hi = k + 1; hipLaunchKernelGGL(mega, dim3(grid), dim3(512), LDS_BYTES, stream, p); }
#endif
}
```

```cpp
#include <hip/hip_runtime.h>
#include <hip/hip_cooperative_groups.h>
#include <cstdio>
#include <cstdint>
namespace cg = cooperative_groups;
namespace pg8 {
#define PG8_LAS __attribute__((address_space(3)))
typedef unsigned short bf16_t;
typedef short bf16x8 __attribute__((ext_vector_type(8)));
typedef float f32x4 __attribute__((ext_vector_type(4)));
typedef unsigned u32x4 __attribute__((ext_vector_type(4)));
constexpr int BM = 256, BK = 64, HALF = 128, HTB = HALF * BK * 2  , STAGE_BYTES = 8 * HTB, NXCD = 8, WGM = 8;

__host__ __device__ __forceinline__ int lds_byte(int r, int c) { const int st = (r >> 4) * 2 + (c >> 5), rr = r & 15, cc = c & 31, ob = rr * 64 + cc * 2; return st * 1024 + (ob ^ (((ob >> 9) & 1) << 5)); }
__host__ __device__ __forceinline__ void stage_rc(int b, int& R, int& C) { const int st = b / 1024, sb = b % 1024, swz = sb ^ (((sb >> 9) & 1) << 5); R = (st >> 1) * 16 + swz / 64; C = (st & 1) * 32 + (swz % 64) / 2; }
__host__ __device__ __forceinline__ int perm32(int rho) { const int n = rho >> 4, i = rho & 15; return 8 * (i >> 2) + 4 * n + (i & 3); }

struct Unit { int pm, pn; };
struct Gemm { const bf16_t* A; const bf16_t* Bt; int M, N, K; };
struct StaticOrder {
    int nM, nN, nwg, G, c;
    __host__ __device__ void init(int M, int N, int G_, int c_) { nM = M / BM; nN = N / BM; nwg = nM * nN; G = G_; c = c_; }
    __host__ __device__ bool next(int i, Unit& u) const {
        const long L = (long)i * G + c; if (L >= nwg) return false;
        int wgid = (int)L; { const int q = nwg / NXCD, r = nwg % NXCD, xcd = wgid % NXCD, off = wgid / NXCD; wgid = (xcd < r ? xcd * (q + 1) : r * (q + 1) + (xcd - r) * q) + off; }
        const int nig = WGM * nN, gid = wgid / nig, fm = gid * WGM, gsz = (nM - fm) < WGM ? (nM - fm) : WGM;
        u.pm = fm + ((wgid % nig) % gsz); u.pn = (wgid % nig) / gsz; return true;
    }
    __device__ __forceinline__ void a_ready(const Unit&) const {}
    __device__ __forceinline__ void done(const Unit&) const {}
};

__device__ __forceinline__ unsigned cvt_pk_bf16(float lo, float hi) { unsigned r; asm volatile("v_cvt_pk_bf16_f32 %0, %1, %2" : "=v"(r) : "v"(lo), "v"(hi)); return r; }
typedef float f32x2 __attribute__((ext_vector_type(2)));
template <class Epi, class Sched, bool ALIGN_EPI = false, bool SP2 = false>
__device__ __forceinline__ void gemm_phase(PG8_LAS unsigned char* lds, const Gemm g, const Sched& S, const Epi& E) {
    const int tid = threadIdx.x, wid = __builtin_amdgcn_readfirstlane(tid >> 6), lane = tid & 63, wr = wid >> 2, wc = wid & 3, fr = lane & 15, fq = lane >> 4;
    const int K = g.K, nt = K / BK;
    unsigned voffA[2], voffB[2];
#pragma unroll
    for (int i = 0; i < 2; ++i) { int R, C; stage_rc(tid * 16 + i * 8192, R, C); const int Rb = Epi::PERM ? ((R & ~31) + perm32(R & 31)) : R;
        voffA[i] = (unsigned)(R * K + C) * 2u; voffB[i] = (unsigned)(Rb * K + C) * 2u; }
    const size_t kstep = (size_t)(BK * 2);
    const size_t hstep = (size_t)HALF * K * 2;
    const size_t tstep = 2 * hstep;
    const unsigned ldsw = (unsigned)wid * 1024u;
    const int aoff = lds_byte(wr * 64 + fr, fq * 8), boff = lds_byte(wc * 32 + fr, fq * 8);
#define PG8_SA(b, h) (((b) * 2 + (h)) * HTB)
#define PG8_SB(b, h) ((4 + (b) * 2 + (h)) * HTB)
#define PG8_STAGE(bufoff, gbase, voff) do { _Pragma("unroll") for (int _i = 0; _i < 2; ++_i) \
        __builtin_amdgcn_global_load_lds((const unsigned*)((const char*)(gbase) + (voff)[_i]), (PG8_LAS unsigned*)(lds + (bufoff) + ldsw + _i * 8192), 16, 0, 0); } while (0)
#define PG8_LDA(dst, b, h) do { _Pragma("unroll") for (int m = 0; m < 4; ++m) _Pragma("unroll") for (int k = 0; k < 2; ++k) dst[m][k] = *(const PG8_LAS bf16x8*)(lds + PG8_SA(b, h) + aoff + m * 2048 + k * 1024); } while (0)
#define PG8_LDB(dst, b, h) do { _Pragma("unroll") for (int n = 0; n < 2; ++n) _Pragma("unroll") for (int k = 0; k < 2; ++k) dst[n][k] = *(const PG8_LAS bf16x8*)(lds + PG8_SB(b, h) + boff + n * 2048 + k * 1024); } while (0)
#define PG8_MMA(ai, bj, At, Bt) do { __builtin_amdgcn_s_setprio(1); _Pragma("unroll") for (int m = 0; m < 4; ++m) _Pragma("unroll") for (int n = 0; n < 2; ++n) _Pragma("unroll") for (int k = 0; k < 2; ++k) \
        acc[ai][bj][m][n] = __builtin_amdgcn_mfma_f32_16x16x32_bf16(Bt[n][k], At[m][k], acc[ai][bj][m][n], 0, 0, 0); __builtin_amdgcn_s_setprio(0); } while (0)
#define PG8_WAIT_V(n) asm volatile("s_waitcnt vmcnt(" #n ")" ::: "memory")
#define PG8_WAIT_L(n) asm volatile("s_waitcnt lgkmcnt(" #n ")" ::: "memory")
#define PG8_BAR __builtin_amdgcn_s_barrier()
#define PG8_SCHED __builtin_amdgcn_sched_barrier(0)
    Unit cur, nxt; int ui = 0;
    if (!S.next(0, cur)) return;
    f32x4 acc[2][2][4][2];
#pragma unroll
    for (int a = 0; a < 2; ++a)
#pragma unroll
        for (int b = 0; b < 2; ++b)
#pragma unroll
            for (int m = 0; m < 4; ++m)
#pragma unroll
                for (int n = 0; n < 2; ++n) acc[a][b][m][n] = (f32x4){0.f, 0.f, 0.f, 0.f};
    bf16x8 At[4][2], B0[2][2], B1[2][2];
    const char* cA = (const char*)g.A + (size_t)cur.pm * tstep; const char* cB = (const char*)g.Bt + (size_t)cur.pn * tstep;
    S.a_ready(cur);
    if constexpr (SP2) {
        PG8_STAGE(PG8_SB(0, 0), cB, voffB); PG8_STAGE(PG8_SB(0, 1), cB + hstep, voffB); PG8_STAGE(PG8_SA(0, 0), cA, voffA); PG8_STAGE(PG8_SA(0, 1), cA + hstep, voffA);
        if (wr == 1) PG8_BAR;
        PG8_WAIT_V(2); PG8_BAR;
        PG8_STAGE(PG8_SB(1, 0), cB + kstep, voffB); PG8_STAGE(PG8_SA(1, 0), cA + kstep, voffA); PG8_STAGE(PG8_SB(1, 1), cB + hstep + kstep, voffB);
        PG8_WAIT_V(6); PG8_BAR;
    } else {
        PG8_STAGE(PG8_SB(0, 0), cB, voffB); PG8_STAGE(PG8_SA(0, 0), cA, voffA); PG8_STAGE(PG8_SB(0, 1), cB + hstep, voffB); PG8_STAGE(PG8_SA(0, 1), cA + hstep, voffA);
        if (wr == 1) PG8_BAR;
        PG8_WAIT_V(4); PG8_BAR;
        PG8_STAGE(PG8_SB(1, 0), cB + kstep, voffB); PG8_STAGE(PG8_SA(1, 0), cA + kstep, voffA); PG8_STAGE(PG8_SB(1, 1), cB + hstep + kstep, voffB);
        PG8_WAIT_V(6); PG8_BAR;
    }
    for (;;) {
        const bool has_next = S.next(ui + 1, nxt);
        const char* nA = has_next ? (const char*)g.A + (size_t)nxt.pm * tstep : cA; const char* nB = has_next ? (const char*)g.Bt + (size_t)nxt.pn * tstep : cB;
        for (int t = 0; t < nt; t += 2) {
            const bool last = (t == nt - 2);
            const char* a1 = cA + (size_t)(t + 1) * kstep;
            const char* a2 = last ? nA : cA + (size_t)(t + 2) * kstep; const char* b2 = last ? nB : cB + (size_t)(t + 2) * kstep;
            const char* a3 = a2 + kstep; const char* b3 = b2 + kstep;
            if (last && has_next) S.a_ready(nxt);
            if constexpr (SP2) {
            PG8_LDB(B0, 0, 0); PG8_LDB(B1, 0, 1); PG8_SCHED; PG8_LDA(At, 0, 0); PG8_STAGE(PG8_SA(1, 1), a1 + hstep, voffA);
            PG8_WAIT_V(8); PG8_WAIT_L(0); PG8_BAR; PG8_MMA(0, 0, At, B0); PG8_MMA(0, 1, At, B1); PG8_BAR; PG8_SCHED;
            PG8_LDA(At, 0, 1); PG8_STAGE(PG8_SB(0, 0), b2, voffB); PG8_STAGE(PG8_SB(0, 1), b2 + hstep, voffB); PG8_STAGE(PG8_SA(0, 0), a2, voffA);
            PG8_WAIT_V(8); PG8_WAIT_L(0); PG8_BAR; PG8_MMA(1, 0, At, B0); PG8_MMA(1, 1, At, B1); PG8_BAR; PG8_SCHED;
            PG8_LDB(B0, 1, 0); PG8_LDB(B1, 1, 1); PG8_SCHED; PG8_LDA(At, 1, 0); PG8_STAGE(PG8_SA(0, 1), a2 + hstep, voffA);
            PG8_WAIT_V(8); PG8_WAIT_L(0); PG8_BAR; PG8_MMA(0, 0, At, B0); PG8_MMA(0, 1, At, B1); PG8_BAR; PG8_SCHED;
            PG8_LDA(At, 1, 1); PG8_STAGE(PG8_SB(1, 0), b3, voffB); PG8_STAGE(PG8_SB(1, 1), b3 + hstep, voffB); PG8_STAGE(PG8_SA(1, 0), a3, voffA);
            PG8_WAIT_V(8); PG8_WAIT_L(0); PG8_BAR; PG8_MMA(1, 0, At, B0); PG8_MMA(1, 1, At, B1); PG8_BAR; PG8_SCHED;
            } else {
            PG8_LDB(B0, 0, 0); PG8_SCHED; PG8_LDA(At, 0, 0); PG8_STAGE(PG8_SA(1, 1), a1 + hstep, voffA);
            PG8_WAIT_L(8); PG8_BAR; PG8_WAIT_L(0); PG8_MMA(0, 0, At, B0); PG8_BAR; PG8_SCHED;
            PG8_LDB(B1, 0, 1); PG8_STAGE(PG8_SB(0, 0), b2, voffB);
            PG8_BAR; PG8_WAIT_L(0); PG8_MMA(0, 1, At, B1); PG8_BAR;
            PG8_LDA(At, 0, 1); PG8_STAGE(PG8_SA(0, 0), a2, voffA);
            PG8_BAR; PG8_WAIT_L(0); PG8_MMA(1, 0, At, B0); PG8_BAR; PG8_SCHED;
            PG8_STAGE(PG8_SB(0, 1), b2 + hstep, voffB);
            PG8_WAIT_V(6); PG8_BAR; PG8_MMA(1, 1, At, B1); PG8_BAR;
            PG8_LDB(B0, 1, 0); PG8_SCHED; PG8_LDA(At, 1, 0); PG8_STAGE(PG8_SA(0, 1), a2 + hstep, voffA);
            PG8_WAIT_L(8); PG8_BAR; PG8_WAIT_L(0); PG8_MMA(0, 0, At, B0); PG8_BAR; PG8_SCHED;
            PG8_LDB(B1, 1, 1); PG8_STAGE(PG8_SB(1, 0), b3, voffB);
            PG8_BAR; PG8_WAIT_L(0); PG8_MMA(0, 1, At, B1); PG8_BAR;
            PG8_LDA(At, 1, 1); PG8_STAGE(PG8_SA(1, 0), a3, voffA);
            PG8_BAR; PG8_WAIT_L(0); PG8_MMA(1, 0, At, B0); PG8_BAR; PG8_SCHED;
            PG8_STAGE(PG8_SB(1, 1), b3 + hstep, voffB);
            PG8_WAIT_V(6); PG8_BAR; PG8_MMA(1, 1, At, B1); PG8_BAR;
            }
        }
        if constexpr (ALIGN_EPI) { if (wr == 0) PG8_BAR; }
        if constexpr (!Epi::AFTER_DRAIN) { E(acc, cur, wr, wc, fr, fq); S.done(cur); }
        if (!has_next) break;
#pragma unroll
        for (int a = 0; a < 2; ++a)
#pragma unroll
            for (int b = 0; b < 2; ++b)
#pragma unroll
                for (int m = 0; m < 4; ++m)
#pragma unroll
                    for (int n = 0; n < 2; ++n) acc[a][b][m][n] = (f32x4){0.f, 0.f, 0.f, 0.f};
        cur = nxt; cA = nA; cB = nB; ++ui;
        if constexpr (ALIGN_EPI) { if (wr == 1) PG8_BAR; }
    }
    PG8_WAIT_V(0);
    if constexpr (!ALIGN_EPI) { if (wr == 0) PG8_BAR; }
    PG8_BAR;
    if constexpr (Epi::AFTER_DRAIN) { E.fused(acc, cur, wr, wc, fr, fq, lds, wid, lane); S.done(cur); }
#undef PG8_SA
#undef PG8_SB
#undef PG8_STAGE
#undef PG8_LDA
#undef PG8_LDB
#undef PG8_MMA
#undef PG8_WAIT_V
#undef PG8_WAIT_L
#undef PG8_BAR
#undef PG8_SCHED
}
}

#ifndef PG8_SP2
#define PG8_SP2 true
#endif
#ifndef PG8_ALIGN
#define PG8_ALIGN true
#endif

#define LAS __attribute__((address_space(3)))
typedef unsigned short bf16;
typedef short bf16x8 __attribute__((ext_vector_type(8)));
typedef float f32x4 __attribute__((ext_vector_type(4)));
typedef unsigned v4u __attribute__((ext_vector_type(4)));
typedef unsigned v2u __attribute__((ext_vector_type(2)));

constexpr int DM = 2048, SEQ = 2048, NBATCH = 16, MP = NBATCH * SEQ, MS = 128, MTOK = MP + MS, MPAD = 33024;
constexpr int NA = 7936, NG = 6144, NIN = 14080, DFF = 5632, CONVCH = 3072;
constexpr int CQ = 0, CK = 1024, CV = 1280, CZ = 1536, CXBC = 3584, CDT = 6656, CQM = 6912;
constexpr float EPS = 1e-6f;
constexpr int LDS_BYTES = 147456;

constexpr size_t O_YP = 0, O_YS = O_YP + (size_t)MP * DM, O_PK = O_YS + (size_t)MS * DM, O_PV = O_PK + 524288, O_PMK = O_PV + 524288, O_PMV = O_PMK + 4194304,
                 O_PSSM = O_PMV + 4194304, O_PCONV = O_PSSM + 4194304, O_SK = O_PCONV + 147456, O_SV = O_SK + 4194304, O_SSSM = O_SV + 4194304, O_SCONV = O_SSSM + 33554432,
                 O_END = O_SCONV + 1179648;
constexpr size_t WS_WIN = 0, WS_WM = WS_WIN + (size_t)NIN * 2048 * 2, WS_WSWA = WS_WM + 2048u * 2048 * 2, WS_WSSD = WS_WSWA + 2048u * 1024 * 2, WS_WMEM = WS_WSSD + 2048u * 2048 * 2,
                 WS_WOUT = WS_WMEM + 2048u * 1024 * 2, WS_WGU = WS_WOUT + 2048u * 2048 * 2, WS_WD = WS_WGU + (size_t)2 * DFF * 2048 * 2, WS_XB = WS_WD + (size_t)2048 * DFF * 2,
                 WS_MB = WS_XB + (size_t)MPAD * 2048 * 2, WS_MKV = WS_MB + 4096u * 2048 * 2, WS_BIG = WS_MKV + 4096u * 2048 * 2, WS_MO = WS_BIG + (size_t)MPAD * NA * 2,
                 WS_DT = WS_MO + (size_t)MPAD * 1024 * 2, WS_SSQ = WS_DT + (size_t)MPAD * 32 * 4, WS_RS1 = WS_SSQ + (size_t)MPAD * 32 * 4, WS_RSM = WS_RS1 + (size_t)MPAD * 4,
                 WS_PART = WS_RSM + 4096u * 4, WS_XCX = WS_PART + (size_t)MPAD * 32 * 4, WS_END = WS_XCX + (size_t)MP * 2048 * 2;
constexpr size_t WS_XCBC = WS_WGU;
static_assert((size_t)MP * 1024 * 2 <= WS_XB - WS_WGU, "XCbc fits");
static_assert(WS_END <= 1073741824u, "workspace budget");
constexpr size_t BIG_ACT = 0, BIG_X1B = (size_t)MPAD * DFF * 2;
static_assert(BIG_X1B + (size_t)MPAD * 2048 * 2 <= (size_t)MPAD * NA * 2, "big overlay");
constexpr size_t YP_AO = 0, YP_SO = (size_t)MPAD * 1024 * 2;
static_assert(YP_SO + (size_t)MPAD * 2048 * 2 <= (size_t)MP * DM * 4, "AO/SO fit in y_prompt");

struct KP { const float* in[32]; float* out; unsigned char* ws; int ph_lo, ph_hi; };

__device__ __forceinline__ float bf2f(unsigned v) { return __uint_as_float(v << 16); }
__device__ __forceinline__ unsigned f2bf(float f) { unsigned u = __float_as_uint(f); return (u + 0x7fffu + ((u >> 16) & 1u)) >> 16; }
__device__ __forceinline__ unsigned pk2(float lo, float hi) { return f2bf(lo) | (f2bf(hi) << 16); }
__device__ __forceinline__ float lo16(unsigned w) { return __uint_as_float(w << 16); }
__device__ __forceinline__ float hi16(unsigned w) { return __uint_as_float(w & 0xffff0000u); }
__device__ __forceinline__ float sigmoidf_(float x) { return 1.0f / (1.0f + __expf(-x)); }
__device__ __forceinline__ float siluf_(float x) { return x / (1.0f + __expf(-x)); }
__device__ __forceinline__ float wave_sum(float v) {
#pragma unroll
    for (int o = 1; o < 64; o <<= 1) v += __shfl_xor(v, o);
    return v;
}
__device__ __forceinline__ float wave_max(float v) {
#pragma unroll
    for (int o = 1; o < 64; o <<= 1) v = fmaxf(v, __shfl_xor(v, o));
    return v;
}
__device__ __forceinline__ f32x4 mfma16(bf16x8 a, bf16x8 b, f32x4 c) { return __builtin_amdgcn_mfma_f32_16x16x32_bf16(a, b, c, 0, 0, 0); }
#define UNPACK8(W_, F_) do { F_[0] = lo16((W_)[0]); F_[1] = hi16((W_)[0]); F_[2] = lo16((W_)[1]); F_[3] = hi16((W_)[1]); F_[4] = lo16((W_)[2]); F_[5] = hi16((W_)[2]); F_[6] = lo16((W_)[3]); F_[7] = hi16((W_)[3]); } while (0)

template <int ACT> struct EpiProj {
    static constexpr bool PERM = true, AFTER_DRAIN = false;
    bf16* O; int ldc; const float* rs; float* f32o; int fc0, fw, fld;
    __device__ __forceinline__ void operator()(const pg8::f32x4 (&acc)[2][2][4][2], const pg8::Unit& u, int wr, int wc, int fr, int fq) const {
#pragma unroll
        for (int ai = 0; ai < 2; ++ai)
#pragma unroll
            for (int m = 0; m < 4; ++m) {
                const int row = u.pm * 256 + ai * 128 + wr * 64 + m * 16 + fr; const float s = rs[row];
#pragma unroll
                for (int bj = 0; bj < 2; ++bj) {
                    const int col = u.pn * 256 + bj * 128 + wc * 32 + 8 * fq;
                    f32x4 v0 = acc[ai][bj][m][0] * s, v1 = acc[ai][bj][m][1] * s;
                    if (ACT == 1) { v0[0] = sigmoidf_(v0[0]); v0[1] = sigmoidf_(v0[1]); v0[2] = sigmoidf_(v0[2]); v0[3] = sigmoidf_(v0[3]);
                                    v1[0] = sigmoidf_(v1[0]); v1[1] = sigmoidf_(v1[1]); v1[2] = sigmoidf_(v1[2]); v1[3] = sigmoidf_(v1[3]); }
                    v4u w; w.x = pk2(v0[0], v0[1]); w.y = pk2(v0[2], v0[3]); w.z = pk2(v1[0], v1[1]); w.w = pk2(v1[2], v1[3]);
                    *(v4u*)(O + (size_t)row * ldc + col) = w;
                    if (f32o && col >= fc0 && col < fc0 + fw) { float* d = f32o + (size_t)row * fld + (col - fc0); *(f32x4*)d = v0; *(f32x4*)(d + 4) = v1; }
                }
            }
    }
};
template <int ACCUM> struct EpiMerge {
    static constexpr bool PERM = true, AFTER_DRAIN = false;
    bf16* MG; const bf16* G;
    __device__ __forceinline__ void operator()(const pg8::f32x4 (&acc)[2][2][4][2], const pg8::Unit& u, int wr, int wc, int fr, int fq) const {
#pragma unroll
        for (int ai = 0; ai < 2; ++ai)
#pragma unroll
            for (int m = 0; m < 4; ++m) {
                const int row = u.pm * 256 + ai * 128 + wr * 64 + m * 16 + fr;
#pragma unroll
                for (int bj = 0; bj < 2; ++bj) {
                    const int col = u.pn * 256 + bj * 128 + wc * 32 + 8 * fq;
                    const v4u gw = *(const v4u*)(G + (size_t)row * NG + col);
                    float g[8]; UNPACK8(gw, g);
                    const f32x4 a0 = acc[ai][bj][m][0], a1 = acc[ai][bj][m][1];
                    float v[8] = {g[0] * a0[0], g[1] * a0[1], g[2] * a0[2], g[3] * a0[3], g[4] * a1[0], g[5] * a1[1], g[6] * a1[2], g[7] * a1[3]};
                    bf16* dst = MG + (size_t)row * 2048 + col;
                    if (ACCUM) { const v4u ow = *(const v4u*)dst; float o[8]; UNPACK8(ow, o);
#pragma unroll
                        for (int e = 0; e < 8; ++e) v[e] += o[e]; }
                    v4u w; w.x = pk2(v[0], v[1]); w.y = pk2(v[2], v[3]); w.z = pk2(v[4], v[5]); w.w = pk2(v[6], v[7]);
                    *(v4u*)dst = w;
                }
            }
    }
};
struct EpiWout {
    static constexpr bool PERM = true, AFTER_DRAIN = false;
    const float* xp; const float* xs; float* yp; float* ys; bf16* X1B; float* part;
    __device__ __forceinline__ void operator()(const pg8::f32x4 (&acc)[2][2][4][2], const pg8::Unit& u, int wr, int wc, int fr, int fq) const {
#pragma unroll
        for (int ai = 0; ai < 2; ++ai)
#pragma unroll
            for (int m = 0; m < 4; ++m) {
                const int row = u.pm * 256 + ai * 128 + wr * 64 + m * 16 + fr;
                const float* xr = row < MP ? xp + (size_t)row * DM : xs + (size_t)(row - MP) * DM;
                float* yr = row < MP ? yp + (size_t)row * DM : ys + (size_t)(row - MP) * DM;
                const bool live = row < MTOK;
                float ps = 0.f;
#pragma unroll
                for (int bj = 0; bj < 2; ++bj) {
                    const int col = u.pn * 256 + bj * 128 + wc * 32 + 8 * fq;
                    f32x4 v0 = {0.f, 0.f, 0.f, 0.f}, v1 = {0.f, 0.f, 0.f, 0.f};
                    if (live) { v0 = *(const f32x4*)(xr + col) + acc[ai][bj][m][0]; v1 = *(const f32x4*)(xr + col + 4) + acc[ai][bj][m][1];
                                *(f32x4*)(yr + col) = v0; *(f32x4*)(yr + col + 4) = v1; }
                    v4u w; w.x = pk2(v0[0], v0[1]); w.y = pk2(v0[2], v0[3]); w.z = pk2(v1[0], v1[1]); w.w = pk2(v1[2], v1[3]);
                    *(v4u*)(X1B + (size_t)row * DM + col) = w;
                    ps += (v0[0] * v0[0] + v0[1] * v0[1]) + (v0[2] * v0[2] + v0[3] * v0[3]) + (v1[0] * v1[0] + v1[1] * v1[1]) + (v1[2] * v1[2] + v1[3] * v1[3]);
                }
                ps += __shfl_xor(ps, 16); ps += __shfl_xor(ps, 32);
                if (fq == 0) part[(size_t)row * 32 + u.pn * 4 + wc] = ps;
            }
    }
};
struct EpiFfnUp {
    static constexpr bool PERM = true, AFTER_DRAIN = false;
    const float* part; bf16* ACT;
    __device__ __forceinline__ void operator()(const pg8::f32x4 (&acc)[2][2][4][2], const pg8::Unit& u, int wr, int wc, int fr, int fq) const {
#pragma unroll
        for (int ai = 0; ai < 2; ++ai)
#pragma unroll
            for (int m = 0; m < 4; ++m) {
                const int row = u.pm * 256 + ai * 128 + wr * 64 + m * 16 + fr;
                const f32x4* pp = (const f32x4*)(part + (size_t)row * 32);
                float ss = 0.f;
#pragma unroll
                for (int i = 0; i < 8; ++i) { const f32x4 t = pp[i]; ss += (t[0] + t[1]) + (t[2] + t[3]); }
                const float rs = rsqrtf(ss * (1.0f / DM) + EPS);
                const f32x4 g0 = acc[ai][0][m][0] * rs, g1 = acc[ai][0][m][1] * rs, u0 = acc[ai][1][m][0] * rs, u1 = acc[ai][1][m][1] * rs;
                v4u w; w.x = pk2(siluf_(g0[0]) * u0[0], siluf_(g0[1]) * u0[1]); w.y = pk2(siluf_(g0[2]) * u0[2], siluf_(g0[3]) * u0[3]);
                w.z = pk2(siluf_(g1[0]) * u1[0], siluf_(g1[1]) * u1[1]); w.w = pk2(siluf_(g1[2]) * u1[2], siluf_(g1[3]) * u1[3]);
                *(v4u*)(ACT + (size_t)row * DFF + u.pn * 128 + wc * 32 + 8 * fq) = w;
            }
    }
};
struct EpiDown {
    static constexpr bool PERM = true, AFTER_DRAIN = false;
    float* yp; float* ys;
    __device__ __forceinline__ void operator()(const pg8::f32x4 (&acc)[2][2][4][2], const pg8::Unit& u, int wr, int wc, int fr, int fq) const {
#pragma unroll
        for (int ai = 0; ai < 2; ++ai)
#pragma unroll
            for (int m = 0; m < 4; ++m) {
                const int row = u.pm * 256 + ai * 128 + wr * 64 + m * 16 + fr;
                if (row < MTOK) {
                    float* yr = row < MP ? yp + (size_t)row * DM : ys + (size_t)(row - MP) * DM;
#pragma unroll
                    for (int bj = 0; bj < 2; ++bj) {
                        const int col = u.pn * 256 + bj * 128 + wc * 32 + 8 * fq;
                        *(f32x4*)(yr + col) = *(const f32x4*)(yr + col) + acc[ai][bj][m][0];
                        *(f32x4*)(yr + col + 4) = *(const f32x4*)(yr + col + 4) + acc[ai][bj][m][1];
                    }
                }
            }
    }
};

__device__ __forceinline__ int maprow(int mode, int n0) {
    if (mode == 1) return n0 < 6688 ? n0 : n0 + 224;
    if (mode == 2) return (n0 >> 7) * 256 + (n0 & 127);
    if (mode == 3) return (n0 >> 7) * 256 + 128 + (n0 & 127);
    return n0;
}
__device__ __forceinline__ void tr_item(const float* W, int K, int N, bf16* WT, const float* gain, int mode, LAS float* scr, int item, int lane) {
    const int nblk = N / 32, kb = item / nblk, nb = item % nblk, k0 = 64 * kb, n0 = 32 * nb;
#pragma unroll 8
    for (int i = 0; i < 32; ++i) { const int kk = 2 * i + (lane >> 5); float v = W[(size_t)(k0 + kk) * N + n0 + (lane & 31)]; if (gain) v *= gain[k0 + kk]; scr[kk * 33 + (lane & 31)] = v; }
    asm volatile("s_waitcnt lgkmcnt(0)" ::: "memory");
    const int c = lane & 7, d0 = maprow(mode, n0);
#pragma unroll
    for (int j = 0; j < 4; ++j) { const int n = (lane >> 3) + 8 * j; const LAS float* s = scr + (8 * c) * 33 + n;
        v4u o; o.x = pk2(s[0 * 33], s[1 * 33]); o.y = pk2(s[2 * 33], s[3 * 33]); o.z = pk2(s[4 * 33], s[5 * 33]); o.w = pk2(s[6 * 33], s[7 * 33]);
        *(v4u*)(WT + (size_t)(d0 + n) * K + k0 + 8 * c) = o; }
    asm volatile("s_waitcnt lgkmcnt(0)" ::: "memory");
}
__device__ __forceinline__ void row_to_bf16(const float* xrow, bf16* orow, float* rs, int lane) {
    f32x4 v[8]; float s = 0.f;
#pragma unroll
    for (int j = 0; j < 8; ++j) { v[j] = *((const f32x4*)xrow + lane + 64 * j); s += (v[j][0] * v[j][0] + v[j][1] * v[j][1]) + (v[j][2] * v[j][2] + v[j][3] * v[j][3]); }
    s = wave_sum(s);
    if (lane == 0) *rs = rsqrtf(s * (1.0f / DM) + EPS);
#pragma unroll
    for (int j = 0; j < 8; ++j) { v2u w; w.x = pk2(v[j][0], v[j][1]); w.y = pk2(v[j][2], v[j][3]); *((v2u*)orow + lane + 64 * j) = w; }
}
__device__ __forceinline__ void prologue(const KP& p, LAS unsigned char* lds) {
    const int tid = threadIdx.x, lane = tid & 63, wave = tid >> 6;
    const int gw = blockIdx.x * 8 + wave, NGW = gridDim.x * 8;
    unsigned char* ws = p.ws;
    LAS float* scr = (LAS float*)(lds + wave * 8448);
    constexpr int I_IN = 32 * 433, I_M = 32 * 64, I_S = 16 * 64;
    constexpr int NITEMS = I_IN + I_M + I_S + I_M + I_S + I_M;
    for (int it = gw; it < NITEMS; it += NGW) {
        int r = it;
        if (r < I_IN) { tr_item(p.in[10], 2048, 13856, (bf16*)(ws + WS_WIN), p.in[9], 1, scr, r, lane); continue; } r -= I_IN;
        if (r < I_M) { tr_item(p.in[21], 2048, 2048, (bf16*)(ws + WS_WM), p.in[20], 0, scr, r, lane); continue; } r -= I_M;
        if (r < I_S) { tr_item(p.in[24], 1024, 2048, (bf16*)(ws + WS_WSWA), nullptr, 0, scr, r, lane); continue; } r -= I_S;
        if (r < I_M) { tr_item(p.in[25], 2048, 2048, (bf16*)(ws + WS_WSSD), p.in[19], 0, scr, r, lane); continue; } r -= I_M;
        if (r < I_S) { tr_item(p.in[26], 1024, 2048, (bf16*)(ws + WS_WMEM), nullptr, 0, scr, r, lane); continue; } r -= I_S;
        tr_item(p.in[27], 2048, 2048, (bf16*)(ws + WS_WOUT), nullptr, 0, scr, r, lane);
    }
    { v4u* z = (v4u*)((bf16*)(ws + WS_WIN) + (size_t)6688 * 2048); const int nz = 224 * 2048 / 8; const v4u zero = {0u, 0u, 0u, 0u};
      for (int i = blockIdx.x * 512 + tid; i < nz; i += gridDim.x * 512) z[i] = zero; }
    bf16* XB = (bf16*)(ws + WS_XB); float* RS1 = (float*)(ws + WS_RS1);
    for (int r = gw; r < MPAD; r += NGW) {
        if (r < MTOK) { const float* src = r < MP ? p.in[0] + (size_t)r * DM : p.in[1] + (size_t)(r - MP) * DM; row_to_bf16(src, XB + (size_t)r * DM, RS1 + r, lane); }
        else { const v2u zero = {0u, 0u};
#pragma unroll
            for (int j = 0; j < 8; ++j) *((v2u*)(XB + (size_t)r * DM) + lane + 64 * j) = zero;
            if (lane == 0) RS1[r] = 0.f; }
    }
    bf16* MB = (bf16*)(ws + WS_MB); float* RSM = (float*)(ws + WS_RSM);
    for (int r = gw; r < 4096; r += NGW) row_to_bf16(p.in[8] + (size_t)r * DM, MB + (size_t)r * DM, RSM + r, lane);
}

__device__ __forceinline__ void late_weights(const KP& p, LAS unsigned char* lds) {
    const int tid = threadIdx.x, lane = tid & 63, wave = tid >> 6;
    const int gw = blockIdx.x * 8 + wave, NGW = gridDim.x * 8;
    unsigned char* ws = p.ws;
    LAS float* scr = (LAS float*)(lds + wave * 8448);
    constexpr int I_G = 32 * 176, I_D = 88 * 64;
    for (int it = gw; it < 2 * I_G + I_D; it += NGW) {
        int r = it;
        if (r < I_G) { tr_item(p.in[29], 2048, DFF, (bf16*)(ws + WS_WGU), p.in[28], 2, scr, r, lane); continue; } r -= I_G;
        if (r < I_G) { tr_item(p.in[30], 2048, DFF, (bf16*)(ws + WS_WGU), p.in[28], 3, scr, r, lane); continue; } r -= I_G;
        tr_item(p.in[31], DFF, 2048, (bf16*)(ws + WS_WD), nullptr, 0, scr, r, lane);
    }
}
__device__ __forceinline__ void conv_prepass(const KP& p) {
    const bf16* PA = (const bf16*)(p.ws + WS_BIG);
    bf16* XCx = (bf16*)(p.ws + WS_XCX); bf16* XCbc = (bf16*)(p.ws + WS_XCBC);
    const int gthreads = gridDim.x * 512;
    for (int task = blockIdx.x * 512 + threadIdx.x; task < NBATCH * 64 * 384; task += gthreads) {
        const int cgp = task % 384, strip = (task / 384) & 63, b = task / (384 * 64);
        const int ch0 = cgp * 8;
        float cw0[8], cw1[8], cw2[8], cw3[8], cbv[8];
#pragma unroll
        for (int e = 0; e < 8; ++e) { cw0[e] = p.in[14][ch0 + e]; cw1[e] = p.in[14][CONVCH + ch0 + e]; cw2[e] = p.in[14][2 * CONVCH + ch0 + e]; cw3[e] = p.in[14][3 * CONVCH + ch0 + e]; cbv[e] = p.in[15][ch0 + e]; }
        const bf16* src = PA + (size_t)(b * SEQ) * NA + CXBC + ch0;
        bf16* dst = ch0 < 2048 ? XCx + (size_t)(b * SEQ) * 2048 + ch0 : XCbc + (size_t)(b * SEQ) * 1024 + (ch0 - 2048);
        const int ldd = ch0 < 2048 ? 2048 : 1024;
        const int t0 = strip * 32;
        float r0[8], r1[8], r2[8];
        {   v4u z0 = {0u, 0u, 0u, 0u}, z1 = z0, z2 = z0;
            if (t0 > 0) { z0 = *(const v4u*)(src + (size_t)(t0 - 3) * NA); z1 = *(const v4u*)(src + (size_t)(t0 - 2) * NA); z2 = *(const v4u*)(src + (size_t)(t0 - 1) * NA); }
            UNPACK8(z0, r0); UNPACK8(z1, r1); UNPACK8(z2, r2); }
#pragma unroll 8
        for (int l = 0; l < 32; ++l) {
            const v4u zc = *(const v4u*)(src + (size_t)(t0 + l) * NA);
            float cur[8], ov[8]; UNPACK8(zc, cur);
#pragma unroll
            for (int e = 0; e < 8; ++e) { const float v = cw0[e] * r0[e] + cw1[e] * r1[e] + cw2[e] * r2[e] + cw3[e] * cur[e] + cbv[e]; ov[e] = siluf_(v); r0[e] = r1[e]; r1[e] = r2[e]; r2[e] = cur[e]; }
            v4u o; o.x = pk2(ov[0], ov[1]); o.y = pk2(ov[2], ov[3]); o.z = pk2(ov[4], ov[5]); o.w = pk2(ov[6], ov[7]);
            *(v4u*)(dst + (size_t)(t0 + l) * ldd) = o;
        }
        if (strip == 63) {
            float* d = p.out + O_PCONV + (size_t)(b * 3) * CONVCH + ch0;
            *(f32x4*)d = (f32x4){r0[0], r0[1], r0[2], r0[3]}; *(f32x4*)(d + 4) = (f32x4){r0[4], r0[5], r0[6], r0[7]};
            *(f32x4*)(d + CONVCH) = (f32x4){r1[0], r1[1], r1[2], r1[3]}; *(f32x4*)(d + CONVCH + 4) = (f32x4){r1[4], r1[5], r1[6], r1[7]};
            *(f32x4*)(d + 2 * CONVCH) = (f32x4){r2[0], r2[1], r2[2], r2[3]}; *(f32x4*)(d + 2 * CONVCH + 4) = (f32x4){r2[4], r2[5], r2[6], r2[7]};
        }
    }
}

#define LDSP(T, off) ((LAS T*)(lds + (off)))

__device__ __forceinline__ void swa_prompt_item(const KP& p, LAS unsigned char* lds, int item) {
    const int tid = threadIdx.x, lane = tid & 63, w = tid >> 6, fr = lane & 15, fq = lane >> 4;
    const int h = item & 15, blk = (item >> 4) & 15, b = item >> 8, kvh = h >> 2;
    LAS bf16* Qs = LDSP(bf16, 0);
    LAS bf16* Ks = LDSP(bf16, 18432);
    LAS bf16* Vt = LDSP(bf16, 57600);
    LAS bf16* Ps = LDSP(bf16, 93440) + w * (16 * 168);
    const bf16* PA = (const bf16*)(p.ws + WS_BIG);
    bf16* AO = (bf16*)((unsigned char*)(p.out + O_YP) + YP_AO);
    const float* qw = p.in[11]; const float* kw = p.in[12];
    {
        const int c = tid >> 1, half = tid & 1, s = (blk - 1) * 128 + c;
        v4u kz[4], vz[4];
        if (s >= 0) { const bf16* src = PA + (size_t)(b * SEQ + s) * NA + kvh * 64 + half * 32;
#pragma unroll
            for (int i = 0; i < 4; ++i) { kz[i] = *(const v4u*)(src + CK + i * 8); vz[i] = *(const v4u*)(src + CV + i * 8); } }
        else {
#pragma unroll
            for (int i = 0; i < 4; ++i) { kz[i] = (v4u){0u, 0u, 0u, 0u}; vz[i] = (v4u){0u, 0u, 0u, 0u}; } }
        float kf[32], vf[32];
#pragma unroll
        for (int i = 0; i < 4; ++i) { float t[8]; UNPACK8(kz[i], t);
#pragma unroll
            for (int e = 0; e < 8; ++e) kf[i * 8 + e] = t[e];
            UNPACK8(vz[i], t);
#pragma unroll
            for (int e = 0; e < 8; ++e) vf[i * 8 + e] = t[e]; }
        float ss = 0.f;
#pragma unroll
        for (int e = 0; e < 32; ++e) ss += kf[e] * kf[e];
        ss += __shfl_xor(ss, 1);
        const float rs = rsqrtf(ss * (1.0f / 64.0f) + EPS);
#pragma unroll
        for (int e = 0; e < 32; ++e) kf[e] = kf[e] * rs * kw[half * 32 + e];
#pragma unroll
        for (int i = 0; i < 4; ++i) { v4u o; o.x = pk2(kf[i * 8 + 0], kf[i * 8 + 1]); o.y = pk2(kf[i * 8 + 2], kf[i * 8 + 3]); o.z = pk2(kf[i * 8 + 4], kf[i * 8 + 5]); o.w = pk2(kf[i * 8 + 6], kf[i * 8 + 7]);
            *(LAS v4u*)(Ks + c * 72 + half * 32 + i * 8) = o; }
#pragma unroll
        for (int e = 0; e < 32; ++e) Vt[(half * 32 + e) * 280 + c] = (bf16)(__float_as_uint(vf[e]) >> 16);
        if (blk == 15 && c >= 128 && (h & 3) == 0) {
            float* dk = p.out + O_PK + ((size_t)(b * 128 + (c - 128)) * 4 + kvh) * 64 + half * 32;
            float* dv = p.out + O_PV + ((size_t)(b * 128 + (c - 128)) * 4 + kvh) * 64 + half * 32;
#pragma unroll
            for (int i = 0; i < 8; ++i) { *(f32x4*)(dk + i * 4) = (f32x4){kf[i * 4], kf[i * 4 + 1], kf[i * 4 + 2], kf[i * 4 + 3]}; *(f32x4*)(dv + i * 4) = (f32x4){vf[i * 4], vf[i * 4 + 1], vf[i * 4 + 2], vf[i * 4 + 3]}; }
        }
    }
    if (tid < 144) *(LAS v4u*)(Ks + 256 * 72 + tid * 8) = (v4u){0u, 0u, 0u, 0u};
    if (tid < 192) { const int d = tid / 3, j = tid % 3; *(LAS v4u*)(Vt + d * 280 + 256 + 8 * j) = (v4u){0u, 0u, 0u, 0u}; }
    {
        const int r = tid >> 2, qd = tid & 3;
        const bf16* src = PA + (size_t)(b * SEQ + blk * 128 + r) * NA + CQ + h * 64 + qd * 16;
        const v4u q0 = *(const v4u*)src, q1 = *(const v4u*)(src + 8);
        float qf[16]; { float t[8]; UNPACK8(q0, t);
#pragma unroll
            for (int e = 0; e < 8; ++e) qf[e] = t[e];
            UNPACK8(q1, t);
#pragma unroll
            for (int e = 0; e < 8; ++e) qf[8 + e] = t[e]; }
        float ss = 0.f;
#pragma unroll
        for (int e = 0; e < 16; ++e) ss += qf[e] * qf[e];
        ss += __shfl_xor(ss, 1); ss += __shfl_xor(ss, 2);
        const float rs = rsqrtf(ss * (1.0f / 64.0f) + EPS) * 0.125f;
#pragma unroll
        for (int e = 0; e < 16; ++e) qf[e] = qf[e] * rs * qw[qd * 16 + e];
        v4u o0, o1; o0.x = pk2(qf[0], qf[1]); o0.y = pk2(qf[2], qf[3]); o0.z = pk2(qf[4], qf[5]); o0.w = pk2(qf[6], qf[7]);
        o1.x = pk2(qf[8], qf[9]); o1.y = pk2(qf[10], qf[11]); o1.z = pk2(qf[12], qf[13]); o1.w = pk2(qf[14], qf[15]);
        *(LAS v4u*)(Qs + r * 72 + qd * 16) = o0; *(LAS v4u*)(Qs + r * 72 + qd * 16 + 8) = o1;
    }
    __syncthreads();
    bf16x8 aq[2];
#pragma unroll
    for (int ks = 0; ks < 2; ++ks) aq[ks] = *(LAS bf16x8*)(Qs + (16 * w + fr) * 72 + ks * 32 + fq * 8);
    f32x4 sc[10];
#pragma unroll
    for (int i = 0; i < 10; ++i) { sc[i] = (f32x4){0.f, 0.f, 0.f, 0.f};
#pragma unroll
        for (int ks = 0; ks < 2; ++ks) { const bf16x8 bk = *(LAS bf16x8*)(Ks + ((w + i) * 16 + fr) * 72 + ks * 32 + fq * 8); sc[i] = mfma16(aq[ks], bk, sc[i]); } }
    const float slope = exp2f(-0.5f * (float)(h + 1)), sink = p.in[13][h];
#pragma unroll
    for (int j = 0; j < 4; ++j) {
        const int r = 16 * w + fq * 4 + j;
        float mx = -INFINITY;
#pragma unroll
        for (int i = 0; i < 10; ++i) { const int c = (w + i) * 16 + fr, dist = 128 + r - c;
            const bool ok = dist >= 0 && dist <= 128 && c < 256 && (blk > 0 || c >= 128);
            const float v = ok ? sc[i][j] - slope * (float)dist : -INFINITY; sc[i][j] = v; mx = fmaxf(mx, v); }
        mx = fmaxf(mx, __shfl_xor(mx, 1)); mx = fmaxf(mx, __shfl_xor(mx, 2)); mx = fmaxf(mx, __shfl_xor(mx, 4)); mx = fmaxf(mx, __shfl_xor(mx, 8));
        mx = fmaxf(mx, sink);
        float sum = 0.f;
#pragma unroll
        for (int i = 0; i < 10; ++i) { const float e = __expf(sc[i][j] - mx); sc[i][j] = e; sum += e; }
        sum += __shfl_xor(sum, 1); sum += __shfl_xor(sum, 2); sum += __shfl_xor(sum, 4); sum += __shfl_xor(sum, 8);
        const float inv = 1.0f / (sum + __expf(sink - mx));
#pragma unroll
        for (int i = 0; i < 10; ++i) Ps[(fq * 4 + j) * 168 + i * 16 + fr] = (bf16)f2bf(sc[i][j] * inv);
    }
    asm volatile("s_waitcnt lgkmcnt(0)" ::: "memory");
    f32x4 o[4];
#pragma unroll
    for (int nt = 0; nt < 4; ++nt) o[nt] = (f32x4){0.f, 0.f, 0.f, 0.f};
#pragma unroll
    for (int ks = 0; ks < 5; ++ks) { const bf16x8 a = *(LAS bf16x8*)(Ps + fr * 168 + ks * 32 + fq * 8);
#pragma unroll
        for (int nt = 0; nt < 4; ++nt) { const bf16x8 bv = *(LAS bf16x8*)(Vt + (nt * 16 + fr) * 280 + w * 16 + ks * 32 + fq * 8); o[nt] = mfma16(a, bv, o[nt]); } }
#pragma unroll
    for (int j = 0; j < 4; ++j) { bf16* dst = AO + (size_t)(b * SEQ + blk * 128 + 16 * w + fq * 4 + j) * 1024 + h * 64 + fr;
#pragma unroll
        for (int nt = 0; nt < 4; ++nt) dst[nt * 16] = (bf16)f2bf(o[nt][j]); }
    __syncthreads();
}

__device__ __forceinline__ void mem_prompt_item(const KP& p, LAS unsigned char* lds, int item) {
    const int tid = threadIdx.x, lane = tid & 63, w = tid >> 6, fr = lane & 15, fq = lane >> 4;
    const int qt = item & 15, h = (item >> 4) & 3, b = item >> 6;
    LAS bf16* Qc = LDSP(bf16, 0);
    LAS bf16* Kc = LDSP(bf16, 18432);
    LAS bf16* Vt = LDSP(bf16, 0);
    LAS bf16* Ps = LDSP(bf16, 55296) + w * (16 * 264);
    LAS float* rq = LDSP(float, 122880); LAS float* rk = LDSP(float, 123392);
    const bf16* PA = (const bf16*)(p.ws + WS_BIG);
    const bf16* MKV = (const bf16*)(p.ws + WS_MKV);
    bf16* MO = (bf16*)(p.ws + WS_MO);
    const float* qw = p.in[22]; const float* kw = p.in[23];
    float ssq_q = 0.f, ssq_k = 0.f;
    f32x4 sc[16];
#pragma unroll
    for (int i = 0; i < 16; ++i) sc[i] = (f32x4){0.f, 0.f, 0.f, 0.f};
    for (int dc = 0; dc < 4; ++dc) {
        {   const int r = tid >> 2, qd = tid & 3;
            const bf16* src = PA + (size_t)(b * SEQ + qt * 128 + r) * NA + CQM + h * 256 + dc * 64 + qd * 16;
            const v4u q0 = *(const v4u*)src, q1 = *(const v4u*)(src + 8);
            float qf[16]; { float t[8]; UNPACK8(q0, t);
#pragma unroll
                for (int e = 0; e < 8; ++e) qf[e] = t[e];
                UNPACK8(q1, t);
#pragma unroll
                for (int e = 0; e < 8; ++e) qf[8 + e] = t[e]; }
#pragma unroll
            for (int e = 0; e < 16; ++e) { ssq_q += qf[e] * qf[e]; qf[e] *= qw[dc * 64 + qd * 16 + e]; }
            v4u o0, o1; o0.x = pk2(qf[0], qf[1]); o0.y = pk2(qf[2], qf[3]); o0.z = pk2(qf[4], qf[5]); o0.w = pk2(qf[6], qf[7]);
            o1.x = pk2(qf[8], qf[9]); o1.y = pk2(qf[10], qf[11]); o1.z = pk2(qf[12], qf[13]); o1.w = pk2(qf[14], qf[15]);
            *(LAS v4u*)(Qc + r * 72 + qd * 16) = o0; *(LAS v4u*)(Qc + r * 72 + qd * 16 + 8) = o1;
        }
        {   const int c = tid >> 1, half = tid & 1;
            const bf16* src = MKV + (size_t)(b * 256 + c) * 2048 + h * 256 + dc * 64 + half * 32;
#pragma unroll
            for (int i = 0; i < 4; ++i) { const v4u kz = *(const v4u*)(src + i * 8); float t[8]; UNPACK8(kz, t);
#pragma unroll
                for (int e = 0; e < 8; ++e) { ssq_k += t[e] * t[e]; t[e] *= kw[dc * 64 + half * 32 + i * 8 + e]; }
                v4u o; o.x = pk2(t[0], t[1]); o.y = pk2(t[2], t[3]); o.z = pk2(t[4], t[5]); o.w = pk2(t[6], t[7]);
                *(LAS v4u*)(Kc + c * 72 + half * 32 + i * 8) = o; }
        }
        __syncthreads();
        bf16x8 aq[2];
#pragma unroll
        for (int ks = 0; ks < 2; ++ks) aq[ks] = *(LAS bf16x8*)(Qc + (16 * w + fr) * 72 + ks * 32 + fq * 8);
#pragma unroll
        for (int i = 0; i < 16; ++i)
#pragma unroll
            for (int ks = 0; ks < 2; ++ks) { const bf16x8 bk = *(LAS bf16x8*)(Kc + (i * 16 + fr) * 72 + ks * 32 + fq * 8); sc[i] = mfma16(aq[ks], bk, sc[i]); }
        __syncthreads();
    }
    ssq_q += __shfl_xor(ssq_q, 1); ssq_q += __shfl_xor(ssq_q, 2); ssq_k += __shfl_xor(ssq_k, 1);
    if ((tid & 3) == 0) rq[tid >> 2] = rsqrtf(ssq_q * (1.0f / 256.0f) + EPS);
    if ((tid & 1) == 0) rk[tid >> 1] = rsqrtf(ssq_k * (1.0f / 256.0f) + EPS);
    __syncthreads();
    {
        float rkv[16];
#pragma unroll
        for (int i = 0; i < 16; ++i) rkv[i] = rk[i * 16 + fr];
#pragma unroll
        for (int j = 0; j < 4; ++j) {
            const float rqv = rq[16 * w + fq * 4 + j] * 0.0625f;
            float mx = -INFINITY;
#pragma unroll
            for (int i = 0; i < 16; ++i) { const float v = sc[i][j] * rqv * rkv[i]; sc[i][j] = v; mx = fmaxf(mx, v); }
            mx = fmaxf(mx, __shfl_xor(mx, 1)); mx = fmaxf(mx, __shfl_xor(mx, 2)); mx = fmaxf(mx, __shfl_xor(mx, 4)); mx = fmaxf(mx, __shfl_xor(mx, 8));
            float sum = 0.f;
#pragma unroll
            for (int i = 0; i < 16; ++i) { const float e = __expf(sc[i][j] - mx); sc[i][j] = e; sum += e; }
            sum += __shfl_xor(sum, 1); sum += __shfl_xor(sum, 2); sum += __shfl_xor(sum, 4); sum += __shfl_xor(sum, 8);
            const float inv = 1.0f / sum;
#pragma unroll
            for (int i = 0; i < 16; ++i) Ps[(fq * 4 + j) * 264 + i * 16 + fr] = (bf16)f2bf(sc[i][j] * inv);
        }
    }
    if (qt == 0) {
        for (int idx = tid; idx < 256 * 32; idx += 512) { const int c = idx >> 5, ch = idx & 31;
            const v4u kz = *(const v4u*)(MKV + (size_t)(b * 256 + c) * 2048 + h * 256 + ch * 8); float t[8]; UNPACK8(kz, t);
            const float r = rk[c];
            float* d = p.out + O_PMK + ((size_t)(b * 256 + c) * 4 + h) * 256 + ch * 8;
            *(f32x4*)d = (f32x4){t[0] * r * kw[ch * 8], t[1] * r * kw[ch * 8 + 1], t[2] * r * kw[ch * 8 + 2], t[3] * r * kw[ch * 8 + 3]};
            *(f32x4*)(d + 4) = (f32x4){t[4] * r * kw[ch * 8 + 4], t[5] * r * kw[ch * 8 + 5], t[6] * r * kw[ch * 8 + 6], t[7] * r * kw[ch * 8 + 7]}; }
    }
    for (int dc = 0; dc < 4; ++dc) {
        {   const int c = tid >> 1, half = tid & 1;
            const bf16* src = MKV + (size_t)(b * 256 + c) * 2048 + 1024 + h * 256 + dc * 64 + half * 32;
#pragma unroll
            for (int i = 0; i < 4; ++i) { const v4u vz = *(const v4u*)(src + i * 8);
                Vt[(half * 32 + i * 8 + 0) * 264 + c] = (bf16)(vz.x & 0xffffu); Vt[(half * 32 + i * 8 + 1) * 264 + c] = (bf16)(vz.x >> 16);
                Vt[(half * 32 + i * 8 + 2) * 264 + c] = (bf16)(vz.y & 0xffffu); Vt[(half * 32 + i * 8 + 3) * 264 + c] = (bf16)(vz.y >> 16);
                Vt[(half * 32 + i * 8 + 4) * 264 + c] = (bf16)(vz.z & 0xffffu); Vt[(half * 32 + i * 8 + 5) * 264 + c] = (bf16)(vz.z >> 16);
                Vt[(half * 32 + i * 8 + 6) * 264 + c] = (bf16)(vz.w & 0xffffu); Vt[(half * 32 + i * 8 + 7) * 264 + c] = (bf16)(vz.w >> 16); }
        }
        __syncthreads();
        f32x4 o[4];
#pragma unroll
        for (int nt = 0; nt < 4; ++nt) o[nt] = (f32x4){0.f, 0.f, 0.f, 0.f};
#pragma unroll
        for (int ks = 0; ks < 8; ++ks) { const bf16x8 a = *(LAS bf16x8*)(Ps + fr * 264 + ks * 32 + fq * 8);
#pragma unroll
            for (int nt = 0; nt < 4; ++nt) { const bf16x8 bv = *(LAS bf16x8*)(Vt + (nt * 16 + fr) * 264 + ks * 32 + fq * 8); o[nt] = mfma16(a, bv, o[nt]); } }
#pragma unroll
        for (int j = 0; j < 4; ++j) { bf16* dst = MO + (size_t)(b * SEQ + qt * 128 + 16 * w + fq * 4 + j) * 1024 + h * 256 + dc * 64 + fr;
#pragma unroll
            for (int nt = 0; nt < 4; ++nt) dst[nt * 16] = (bf16)f2bf(o[nt][j]); }
        __syncthreads();
    }
}

__device__ __forceinline__ float softplusf_(float x) { return x > 20.f ? x : log1pf(__expf(x)); }
typedef short v4i16_t __attribute__((ext_vector_type(4)));
__device__ __forceinline__ bf16x8 tr_frag(LAS bf16* a0, LAS bf16* a1) {
    const v4i16_t lo = __builtin_amdgcn_ds_read_tr16_b64_v4i16((LAS v4i16_t*)a0), hi = __builtin_amdgcn_ds_read_tr16_b64_v4i16((LAS v4i16_t*)a1);
    bf16x8 r; r[0] = lo[0]; r[1] = lo[1]; r[2] = lo[2]; r[3] = lo[3]; r[4] = hi[0]; r[5] = hi[1]; r[6] = hi[2]; r[7] = hi[3]; return r;
}
__device__ __forceinline__ void ssd_prompt_item(const KP& p, LAS unsigned char* lds, int b, int head) {
    const int tid = threadIdx.x, lane = tid & 63, w = tid >> 6, fr = lane & 15, fq = lane >> 4;
    const int g = head >> 3;
    LAS bf16* Xt = LDSP(bf16, 0);
    LAS bf16* Bs = LDSP(bf16, 17408);
    LAS bf16* Cs = LDSP(bf16, 52224);
    LAS bf16* Ws = LDSP(bf16, 87040) + w * (16 * 136);
    LAS bf16* Hs = LDSP(bf16, 121856);
    LAS float* dtv = LDSP(float, 139264); LAS float* acs = LDSP(float, 139776); LAS float* das = LDSP(float, 140288);
    const bf16* PA = (const bf16*)(p.ws + WS_BIG);
    const bf16* XCx = (const bf16*)(p.ws + WS_XCX); const bf16* XCbc = (const bf16*)(p.ws + WS_XCBC);
    const float* DT = (const float*)(p.ws + WS_DT);
    float* SSQ = (float*)(p.ws + WS_SSQ);
    bf16* SO = (bf16*)((unsigned char*)(p.out + O_YP) + YP_SO);
    const float dtb = p.in[16][head], Aneg = -__expf(p.in[17][head]), Dh = p.in[18][head];
    f32x4 hst[4];
#pragma unroll
    for (int i = 0; i < 4; ++i) hst[i] = (f32x4){0.f, 0.f, 0.f, 0.f};
    const int pt = w & 3, nb0 = (w >> 2) * 4;
    const bf16* srcB = XCbc + (size_t)(b * SEQ + (tid >> 4)) * 1024 + g * 128 + (tid & 15) * 8;
    const bf16* srcX = XCx + (size_t)(b * SEQ + (tid >> 3)) * 2048 + head * 64 + (tid & 7) * 8;
    v4u pfB[4], pfC[4], pfX[2]; float pfdt = 0.f;
#pragma unroll
    for (int i = 0; i < 4; ++i) { pfB[i] = *(const v4u*)(srcB + (size_t)(32 * i) * 1024); pfC[i] = *(const v4u*)(srcB + (size_t)(32 * i) * 1024 + 512); }
#pragma unroll
    for (int i = 0; i < 2; ++i) pfX[i] = *(const v4u*)(srcX + (size_t)(64 * i) * 2048);
    if (tid < 128) pfdt = DT[(size_t)(b * SEQ + tid) * 32 + head];
    for (int c = 0; c < 16; ++c) {
        const int t0 = c * 128;
#pragma unroll
        for (int i = 0; i < 4; ++i) { *(LAS v4u*)(Bs + ((tid >> 4) + 32 * i) * 136 + (tid & 15) * 8) = pfB[i]; *(LAS v4u*)(Cs + ((tid >> 4) + 32 * i) * 136 + (tid & 15) * 8) = pfC[i]; }
#pragma unroll
        for (int i = 0; i < 2; ++i) { const int l = (tid >> 3) + 64 * i, p0 = (tid & 7) * 8;
            Xt[(p0 + 0) * 136 + l] = (bf16)(pfX[i].x & 0xffffu); Xt[(p0 + 1) * 136 + l] = (bf16)(pfX[i].x >> 16);
            Xt[(p0 + 2) * 136 + l] = (bf16)(pfX[i].y & 0xffffu); Xt[(p0 + 3) * 136 + l] = (bf16)(pfX[i].y >> 16);
            Xt[(p0 + 4) * 136 + l] = (bf16)(pfX[i].z & 0xffffu); Xt[(p0 + 5) * 136 + l] = (bf16)(pfX[i].z >> 16);
            Xt[(p0 + 6) * 136 + l] = (bf16)(pfX[i].w & 0xffffu); Xt[(p0 + 7) * 136 + l] = (bf16)(pfX[i].w >> 16); }
        if (tid < 128) { const float dt = softplusf_(pfdt + dtb); dtv[tid] = dt; das[tid] = dt * Aneg; }
#pragma unroll
        for (int i = 0; i < 4; ++i)
#pragma unroll
            for (int j = 0; j < 4; ++j) Hs[(pt * 16 + fq * 4 + j) * 136 + (nb0 + i) * 16 + fr] = (bf16)f2bf(hst[i][j]);
        unsigned short zr[16];
#pragma unroll
        for (int j = 0; j < 4; ++j)
#pragma unroll
            for (int nt = 0; nt < 4; ++nt) zr[j * 4 + nt] = PA[(size_t)(b * SEQ + t0 + 16 * w + fq * 4 + j) * NA + CZ + head * 64 + nt * 16 + fr];
        if (c < 15) {
#pragma unroll
            for (int i = 0; i < 4; ++i) { pfB[i] = *(const v4u*)(srcB + (size_t)(t0 + 128 + 32 * i) * 1024); pfC[i] = *(const v4u*)(srcB + (size_t)(t0 + 128 + 32 * i) * 1024 + 512); }
#pragma unroll
            for (int i = 0; i < 2; ++i) pfX[i] = *(const v4u*)(srcX + (size_t)(t0 + 128 + 64 * i) * 2048);
            if (tid < 128) pfdt = DT[(size_t)(b * SEQ + t0 + 128 + tid) * 32 + head];
        }
        __syncthreads();
        if (w == 0) { const float a0 = das[2 * lane], a1 = das[2 * lane + 1]; float s = a0 + a1;
#pragma unroll
            for (int off = 1; off < 64; off <<= 1) { const float t = __shfl_up(s, off); if (lane >= off) s += t; }
            acs[2 * lane + 1] = s; acs[2 * lane] = s - a1; }
        __syncthreads();
        bf16x8 ac[4];
#pragma unroll
        for (int ks = 0; ks < 4; ++ks) ac[ks] = *(LAS bf16x8*)(Cs + (16 * w + fr) * 136 + ks * 32 + fq * 8);
        f32x4 yo[4], yd[4];
#pragma unroll
        for (int nt = 0; nt < 4; ++nt) { yo[nt] = (f32x4){0.f, 0.f, 0.f, 0.f}; yd[nt] = (f32x4){0.f, 0.f, 0.f, 0.f};
#pragma unroll
            for (int ks = 0; ks < 4; ++ks) { const bf16x8 bh = *(LAS bf16x8*)(Hs + (nt * 16 + fr) * 136 + ks * 32 + fq * 8); yo[nt] = mfma16(ac[ks], bh, yo[nt]); } }
        float al[4];
#pragma unroll
        for (int j = 0; j < 4; ++j) al[j] = acs[16 * w + fq * 4 + j];
#pragma unroll
        for (int nt = 0; nt < 8; ++nt) {
            if (nt <= w) {
                f32x4 cb = {0.f, 0.f, 0.f, 0.f};
#pragma unroll
                for (int ks = 0; ks < 4; ++ks) { const bf16x8 bb = *(LAS bf16x8*)(Bs + (nt * 16 + fr) * 136 + ks * 32 + fq * 8); cb = mfma16(ac[ks], bb, cb); }
                const int s = nt * 16 + fr; const float as_ = acs[s], dts = dtv[s];
#pragma unroll
                for (int j = 0; j < 4; ++j) { const int l = 16 * w + fq * 4 + j; const float wv = (s <= l) ? cb[j] * __expf(al[j] - as_) * dts : 0.f; Ws[(fq * 4 + j) * 136 + s] = (bf16)f2bf(wv); }
            } else {
#pragma unroll
                for (int j = 0; j < 4; ++j) Ws[(fq * 4 + j) * 136 + nt * 16 + fr] = (bf16)0;
            }
        }
        asm volatile("s_waitcnt lgkmcnt(0)" ::: "memory");
#pragma unroll
        for (int ks = 0; ks < 4; ++ks) {
            if (2 * ks <= w) { const bf16x8 aw = *(LAS bf16x8*)(Ws + fr * 136 + ks * 32 + fq * 8);
#pragma unroll
                for (int nt = 0; nt < 4; ++nt) { const bf16x8 bx = *(LAS bf16x8*)(Xt + (nt * 16 + fr) * 136 + ks * 32 + fq * 8); yd[nt] = mfma16(aw, bx, yd[nt]); } }
        }
#pragma unroll
        for (int j = 0; j < 4; ++j) {
            const int l = 16 * w + fq * 4 + j; const size_t tok = (size_t)(b * SEQ + t0 + l); const float el = __expf(al[j]);
            float ss = 0.f;
#pragma unroll
            for (int nt = 0; nt < 4; ++nt) { const int pp = nt * 16 + fr; const float xv = bf2f(Xt[pp * 136 + l]);
                const float y = yd[nt][j] + el * yo[nt][j] + Dh * xv;
                const float zv = bf2f(zr[j * 4 + nt]);
                const float yz = y * siluf_(zv); ss += yz * yz; SO[tok * 2048 + head * 64 + pp] = (bf16)f2bf(yz); }
            ss += __shfl_xor(ss, 1); ss += __shfl_xor(ss, 2); ss += __shfl_xor(ss, 4); ss += __shfl_xor(ss, 8);
            if (fr == 0) SSQ[tok * 32 + head] = ss;
        }
        const float aL = acs[127];
        f32x4 st[4];
#pragma unroll
        for (int i = 0; i < 4; ++i) st[i] = (f32x4){0.f, 0.f, 0.f, 0.f};
#pragma unroll
        for (int ks = 0; ks < 4; ++ks) {
            const v4u axr = *(LAS v4u*)(Xt + (pt * 16 + fr) * 136 + ks * 32 + fq * 8);
            float xf[8]; UNPACK8(axr, xf);
#pragma unroll
            for (int e = 0; e < 8; ++e) { const int l = ks * 32 + fq * 8 + e; xf[e] *= __expf(aL - acs[l]) * dtv[l]; }
            v4u pw; pw.x = pk2(xf[0], xf[1]); pw.y = pk2(xf[2], xf[3]); pw.z = pk2(xf[4], xf[5]); pw.w = pk2(xf[6], xf[7]);
            const bf16x8 ax = __builtin_bit_cast(bf16x8, pw);
            LAS bf16* tb = Bs + (ks * 32 + fq * 8 + (fr >> 2)) * 136 + (fr & 3) * 4;
#pragma unroll
            for (int i = 0; i < 4; ++i) { const bf16x8 bb = tr_frag(tb + (nb0 + i) * 16, tb + 4 * 136 + (nb0 + i) * 16); st[i] = mfma16(ax, bb, st[i]); }
        }
        const float eL = __expf(aL);
#pragma unroll
        for (int i = 0; i < 4; ++i) hst[i] = hst[i] * eL + st[i];
        __syncthreads();
    }
#pragma unroll
    for (int i = 0; i < 4; ++i)
#pragma unroll
        for (int j = 0; j < 4; ++j) p.out[O_PSSM + ((size_t)(b * 32 + head) * 64 + pt * 16 + fq * 4 + j) * 128 + (nb0 + i) * 16 + fr] = hst[i][j];
}

__device__ __forceinline__ void ssd_decode_item(const KP& p, LAS unsigned char* lds, int item) {
    const int tid = threadIdx.x, lane = tid & 63;
    const int head = item & 31, b = item >> 5, g = head >> 3;
    const size_t tok = (size_t)(MP + b);
    LAS float* xs = LDSP(float, 0); LAS float* Bv = LDSP(float, 256); LAS float* Cv = LDSP(float, 768); LAS float* red = LDSP(float, 1280);
    const bf16* PA = (const bf16*)(p.ws + WS_BIG);
    const float* DT = (const float*)(p.ws + WS_DT);
    float* SSQ = (float*)(p.ws + WS_SSQ);
    bf16* SO = (bf16*)((unsigned char*)(p.out + O_YP) + YP_SO);
    if (tid < 320) {
        const int ch = tid < 64 ? head * 64 + tid : (tid < 192 ? 2048 + g * 128 + (tid - 64) : 2560 + g * 128 + (tid - 192));
        const float raw = bf2f(PA[tok * NA + CXBC + ch]);
        const float s0 = p.in[7][(size_t)(b * 3 + 0) * CONVCH + ch], s1 = p.in[7][(size_t)(b * 3 + 1) * CONVCH + ch], s2 = p.in[7][(size_t)(b * 3 + 2) * CONVCH + ch];
        const float v = p.in[14][ch] * s0 + p.in[14][CONVCH + ch] * s1 + p.in[14][2 * CONVCH + ch] * s2 + p.in[14][3 * CONVCH + ch] * raw + p.in[15][ch];
        const float o = siluf_(v);
        if (tid < 64) xs[tid] = o; else if (tid < 192) Bv[tid - 64] = o; else Cv[tid - 192] = o;
        if (tid < 64 || (head & 7) == 0) { float* d = p.out + O_SCONV + (size_t)(b * 3) * CONVCH + ch; d[0] = s1; d[CONVCH] = s2; d[2 * CONVCH] = raw; }
    }
    __syncthreads();
    const float dt = softplusf_(DT[tok * 32 + head] + p.in[16][head]);
    const float dA = __expf(dt * (-__expf(p.in[17][head]))), Dh = p.in[18][head];
    const int pp = tid >> 3, q = tid & 7;
    const float xv = xs[pp], xdt = xv * dt;
    const size_t hoff = ((size_t)(b * 32 + head) * 64 + pp) * 128;
    float part = 0.f, cbp = 0.f;
#pragma unroll
    for (int i = 0; i < 4; ++i) {
        const int n = q * 4 + 32 * i;
        const f32x4 hv = *(const f32x4*)(p.in[6] + hoff + n);
        const f32x4 bv = {Bv[n], Bv[n + 1], Bv[n + 2], Bv[n + 3]}, cv = {Cv[n], Cv[n + 1], Cv[n + 2], Cv[n + 3]};
        part += (cv[0] * hv[0] + cv[1] * hv[1]) + (cv[2] * hv[2] + cv[3] * hv[3]);
        cbp += (cv[0] * bv[0] + cv[1] * bv[1]) + (cv[2] * bv[2] + cv[3] * bv[3]);
        *(f32x4*)(p.out + O_SSSM + hoff + n) = hv * dA + bv * xdt;
    }
    part += __shfl_xor(part, 1); part += __shfl_xor(part, 2); part += __shfl_xor(part, 4);
    cbp += __shfl_xor(cbp, 1); cbp += __shfl_xor(cbp, 2); cbp += __shfl_xor(cbp, 4);
    if (q == 0) {
        const float y = cbp * dt * xv + part * dA + Dh * xv;
        const float zv = bf2f(PA[tok * NA + CZ + head * 64 + pp]);
        const float yz = y * siluf_(zv);
        SO[tok * 2048 + head * 64 + pp] = (bf16)f2bf(yz);
        red[pp] = yz * yz;
    }
    __syncthreads();
    if (tid < 64) { const float s = wave_sum(red[lane]); if (lane == 0) SSQ[tok * 32 + head] = s; }
    __syncthreads();
}

__device__ __forceinline__ void swa_decode_item(const KP& p, LAS unsigned char* lds, int item) {
    const int tid = threadIdx.x, lane = tid & 63, w = tid >> 6;
    const int kvh = item & 3, b = item >> 2;
    const size_t tok = (size_t)(MP + b);
    LAS float* Kf = LDSP(float, 0);
    LAS float* Vf = LDSP(float, 33792);
    LAS float* qn = LDSP(float, 66816);
    LAS float* sc = LDSP(float, 67840);
    const bf16* PA = (const bf16*)(p.ws + WS_BIG);
    bf16* AO = (bf16*)((unsigned char*)(p.out + O_YP) + YP_AO);
    for (int idx = tid; idx < 128 * 16; idx += 512) { const int j = idx >> 4, c4 = idx & 15;
        const size_t off = ((size_t)(b * 128 + j) * 4 + kvh) * 64 + c4 * 4;
        const f32x4 kv = *(const f32x4*)(p.in[2] + off), vv = *(const f32x4*)(p.in[3] + off);
        Kf[j * 65 + c4 * 4 + 0] = kv[0]; Kf[j * 65 + c4 * 4 + 1] = kv[1]; Kf[j * 65 + c4 * 4 + 2] = kv[2]; Kf[j * 65 + c4 * 4 + 3] = kv[3];
        *(LAS f32x4*)(Vf + j * 64 + c4 * 4) = vv;
        if (j >= 1) { const size_t o2 = ((size_t)(b * 128 + j - 1) * 4 + kvh) * 64 + c4 * 4; *(f32x4*)(p.out + O_SK + o2) = kv; *(f32x4*)(p.out + O_SV + o2) = vv; } }
    if (w == 0) { const float kr = bf2f(PA[tok * NA + CK + kvh * 64 + lane]); const float ss = wave_sum(kr * kr);
        const float kn = kr * rsqrtf(ss * (1.0f / 64.0f) + EPS) * p.in[12][lane];
        Kf[128 * 65 + lane] = kn; p.out[O_SK + ((size_t)(b * 128 + 127) * 4 + kvh) * 64 + lane] = kn; }
    else if (w == 1) { const float vr = bf2f(PA[tok * NA + CV + kvh * 64 + lane]); Vf[128 * 64 + lane] = vr; p.out[O_SV + ((size_t)(b * 128 + 127) * 4 + kvh) * 64 + lane] = vr; }
    else if (w < 6) { const int hq = w - 2; const float qr = bf2f(PA[tok * NA + CQ + (kvh * 4 + hq) * 64 + lane]); const float ss = wave_sum(qr * qr);
        qn[hq * 64 + lane] = qr * rsqrtf(ss * (1.0f / 64.0f) + EPS) * p.in[11][lane] * 0.125f; }
    __syncthreads();
    for (int idx = tid; idx < 4 * 129; idx += 512) { const int hq = idx / 129, j = idx % 129;
        float d = 0.f;
#pragma unroll 8
        for (int e = 0; e < 64; ++e) d += qn[hq * 64 + e] * Kf[j * 65 + e];
        const float slope = exp2f(-0.5f * (float)(kvh * 4 + hq + 1));
        sc[hq * 132 + j] = d - slope * (float)(128 - j); }
    __syncthreads();
    if (w < 4) { const int hq = w; const float sink = p.in[13][kvh * 4 + hq];
        const float v0 = sc[hq * 132 + lane], v1 = sc[hq * 132 + 64 + lane], v2 = lane == 0 ? sc[hq * 132 + 128] : -INFINITY;
        const float mx = fmaxf(wave_max(fmaxf(fmaxf(v0, v1), v2)), sink);
        const float e0 = __expf(v0 - mx), e1 = __expf(v1 - mx), e2 = lane == 0 ? __expf(v2 - mx) : 0.f;
        const float inv = 1.0f / (wave_sum(e0 + e1 + e2) + __expf(sink - mx));
        sc[hq * 132 + lane] = e0 * inv; sc[hq * 132 + 64 + lane] = e1 * inv; if (lane == 0) sc[hq * 132 + 128] = e2 * inv; }
    __syncthreads();
    if (tid < 256) { const int hq = w; float o = 0.f;
#pragma unroll 4
        for (int j = 0; j < 129; ++j) o += sc[hq * 132 + j] * Vf[j * 64 + lane];
        AO[tok * 1024 + (kvh * 4 + hq) * 64 + lane] = (bf16)f2bf(o); }
    __syncthreads();
}

__device__ __forceinline__ void mem_decode_item(const KP& p, LAS unsigned char* lds, int item) {
    const int tid = threadIdx.x, lane = tid & 63, w = tid >> 6;
    const int h = item & 3, b = item >> 2;
    const size_t tok = (size_t)(MP + b);
    LAS float* sc = LDSP(float, 0); LAS float* part = LDSP(float, 1024);
    const bf16* PA = (const bf16*)(p.ws + WS_BIG);
    bf16* MO = (bf16*)(p.ws + WS_MO);
    float q[4];
    {   const v2u qz = *(const v2u*)(PA + tok * NA + CQM + h * 256 + lane * 4);
        q[0] = lo16(qz.x); q[1] = hi16(qz.x); q[2] = lo16(qz.y); q[3] = hi16(qz.y);
        const float ss = wave_sum((q[0] * q[0] + q[1] * q[1]) + (q[2] * q[2] + q[3] * q[3]));
        const float rs = rsqrtf(ss * (1.0f / 256.0f) + EPS) * 0.0625f;
        const f32x4 wq = *(const f32x4*)(p.in[22] + lane * 4);
        q[0] *= rs * wq[0]; q[1] *= rs * wq[1]; q[2] *= rs * wq[2]; q[3] *= rs * wq[3]; }
    const float* Kb = p.in[4] + ((size_t)(b * 256) * 4 + h) * 256;
    const float* Vb = p.in[5] + ((size_t)(b * 256) * 4 + h) * 256;
#pragma unroll 4
    for (int i = 0; i < 32; ++i) { const int m = w + 8 * i;
        const f32x4 kv = *(const f32x4*)(Kb + (size_t)m * 1024 + lane * 4);
        const float d = wave_sum((q[0] * kv[0] + q[1] * kv[1]) + (q[2] * kv[2] + q[3] * kv[3]));
        if (lane == 0) sc[m] = d; }
    __syncthreads();
    if (w == 0) { const f32x4 v = *(LAS f32x4*)(sc + lane * 4);
        const float mx = wave_max(fmaxf(fmaxf(v[0], v[1]), fmaxf(v[2], v[3])));
        const float e0 = __expf(v[0] - mx), e1 = __expf(v[1] - mx), e2 = __expf(v[2] - mx), e3 = __expf(v[3] - mx);
        const float inv = 1.0f / wave_sum((e0 + e1) + (e2 + e3));
        *(LAS f32x4*)(sc + lane * 4) = (f32x4){e0 * inv, e1 * inv, e2 * inv, e3 * inv}; }
    __syncthreads();
    {   const int half = tid >> 8, d = tid & 255; float o = 0.f;
#pragma unroll 8
        for (int m = half * 128; m < half * 128 + 128; ++m) o += sc[m] * Vb[(size_t)m * 1024 + d];
        part[half * 256 + d] = o; }
    __syncthreads();
    if (tid < 256) MO[tok * 1024 + h * 256 + tid] = (bf16)f2bf(part[tid] + part[256 + tid]);
    __syncthreads();
}

__device__ __forceinline__ void ssd_norm_pass(const KP& p) {
    const int tid = threadIdx.x, lane = tid & 63, wave = tid >> 6;
    const int gw = blockIdx.x * 8 + wave, NGW = gridDim.x * 8;
    const float* SSQ = (const float*)(p.ws + WS_SSQ);
    bf16* SO = (bf16*)((unsigned char*)(p.out + O_YP) + YP_SO);
    for (int r = gw; r < MTOK; r += NGW) {
#pragma unroll
        for (int it = 0; it < 4; ++it) {
            const f32x4 a = *(const f32x4*)(SSQ + (size_t)r * 32 + it * 8), c = *(const f32x4*)(SSQ + (size_t)r * 32 + it * 8 + 4);
            const float rs = rsqrtf(((a[0] + a[1]) + (a[2] + a[3]) + (c[0] + c[1]) + (c[2] + c[3])) * (1.0f / 512.0f) + EPS);
            v4u* ptr = (v4u*)(SO + (size_t)r * 2048 + it * 512 + lane * 8);
            const v4u z = *ptr; float t[8]; UNPACK8(z, t);
            v4u o; o.x = pk2(t[0] * rs, t[1] * rs); o.y = pk2(t[2] * rs, t[3] * rs); o.z = pk2(t[4] * rs, t[5] * rs); o.w = pk2(t[6] * rs, t[7] * rs);
            *ptr = o;
        }
    }
    bf16* AO = (bf16*)((unsigned char*)(p.out + O_YP) + YP_AO); bf16* MO = (bf16*)(p.ws + WS_MO);
    const v4u zero = {0u, 0u, 0u, 0u};
    for (int i = blockIdx.x * 512 + tid; i < (MPAD - MTOK) * 256; i += gridDim.x * 512) *((v4u*)(SO + (size_t)MTOK * 2048) + i) = zero;
    for (int i = blockIdx.x * 512 + tid; i < (MPAD - MTOK) * 128; i += gridDim.x * 512) { *((v4u*)(AO + (size_t)MTOK * 1024) + i) = zero; *((v4u*)(MO + (size_t)MTOK * 1024) + i) = zero; }
}


#ifndef NO_SSDP
#define ITEM_SSDP { int b_, h_; if (G_ == 256) { const int xcd = bid & 7, slot = bid >> 3, gi = (slot >> 3) * 8 + xcd; b_ = (it >> 8) * 8 + (gi >> 2); h_ = (gi & 3) * 8 + (slot & 7); } else { b_ = it >> 5; h_ = it & 31; } ssd_prompt_item(p, lds, b_, h_); }
#else
#define ITEM_SSDP
#endif
#ifndef NO_MEMP
#define ITEM_MEMP mem_prompt_item(p, lds, it);
#else
#define ITEM_MEMP
#endif
#ifndef NO_SWAP
#define ITEM_SWAP swa_prompt_item(p, lds, it);
#else
#define ITEM_SWAP
#endif
#ifndef NO_SSDD
#define ITEM_SSDD ssd_decode_item(p, lds, it);
#else
#define ITEM_SSDD
#endif
#ifndef NO_MEMD
#define ITEM_MEMD mem_decode_item(p, lds, it);
#else
#define ITEM_MEMD
#endif
#ifndef NO_SWAD
#define ITEM_SWAD swa_decode_item(p, lds, it);
#else
#define ITEM_SWAD
#endif

#ifndef REP_P0
#define REP_P0 1
#endif
#ifndef REP_P2
#define REP_P2 1
#endif
#ifndef REP_SSDP
#define REP_SSDP REP_P2
#endif
#ifndef REP_MEMP
#define REP_MEMP REP_P2
#endif
#ifndef REP_SWAP
#define REP_SWAP REP_P2
#endif
#ifndef REP_SSDD
#define REP_SSDD REP_P2
#endif
#ifndef REP_MEMD
#define REP_MEMD REP_P2
#endif
#ifndef REP_SWAD
#define REP_SWAD REP_P2
#endif
#ifndef REP_P6
#define REP_P6 1
#endif
#define GEMM(EpiT, Eobj, Aptr, Bptr, M_, N_, K_, cid) do { pg8::Gemm g_{(const pg8::bf16_t*)(Aptr), (const pg8::bf16_t*)(Bptr), M_, N_, K_}; pg8::StaticOrder S_; S_.init(M_, N_, (int)gridDim.x, (cid)); \
    pg8::gemm_phase<EpiT, pg8::StaticOrder, PG8_ALIGN, PG8_SP2>(lds, g_, S_, Eobj); } while (0)

__global__ void __launch_bounds__(512, 2) mega(KP p) {
    extern __shared__ __attribute__((aligned(16))) unsigned char lds_raw[];
    LAS unsigned char* lds = (LAS unsigned char*)lds_raw;
    cg::grid_group grid = cg::this_grid();
    unsigned char* ws = p.ws;
    const int lo = p.ph_lo, hi = p.ph_hi;
#define IN(k) (lo <= (k) && (k) < hi)
#define SEAM(k) do { if (IN(k) && IN((k) + 1)) grid.sync(); } while (0)
    bf16* XB = (bf16*)(ws + WS_XB); bf16* MG = XB;
    bf16* PA = (bf16*)(ws + WS_BIG); bf16* GATES = PA; bf16* ACT = (bf16*)(ws + WS_BIG + BIG_ACT); bf16* X1B = (bf16*)(ws + WS_BIG + BIG_X1B);
    bf16* AO = (bf16*)((unsigned char*)(p.out + O_YP) + YP_AO); bf16* SO = (bf16*)((unsigned char*)(p.out + O_YP) + YP_SO); bf16* MO = (bf16*)(ws + WS_MO);
    float* RS1 = (float*)(ws + WS_RS1); float* RSM = (float*)(ws + WS_RSM); float* PART = (float*)(ws + WS_PART);
    const int bid = (int)blockIdx.x;

    if (IN(0))
_Pragma("nounroll")
    for (int rep_ = 0; rep_ < REP_P0; ++rep_) { prologue(p, lds); __syncthreads(); }
    SEAM(0);
    if (IN(1)) {
        EpiProj<0> E1{PA, NA, RS1, (float*)(ws + WS_DT), CDT, 32, 32};
        GEMM(EpiProj<0>, E1, XB, ws + WS_WIN, MPAD, NA, 2048, bid);
        EpiProj<0> E2{(bf16*)(ws + WS_MKV), 2048, RSM, p.out + O_PMV, 1024, 1024, 1024};
        GEMM(EpiProj<0>, E2, ws + WS_MB, ws + WS_WM, 4096, 2048, 2048, (int)gridDim.x - 1 - bid);
    }
    SEAM(1);
    if (IN(2)) {
        const int G_ = (int)gridDim.x;
        conv_prepass(p);
        for (int it_ = bid; it_ < 1024 * REP_MEMP; it_ += G_) { const int it = it_ & 1023; ITEM_MEMP }
        for (int it_ = bid; it_ < 4096 * REP_SWAP; it_ += G_) { const int it = it_ & 4095; ITEM_SWAP }
        for (int it_ = bid; it_ < 4096 * REP_SSDD; it_ += G_) { const int it = it_ & 4095; ITEM_SSDD }
        for (int it_ = bid; it_ < 512 * REP_MEMD; it_ += G_) { const int it = it_ & 511; ITEM_MEMD }
        for (int it_ = bid; it_ < 512 * REP_SWAD; it_ += G_) { const int it = it_ & 511; ITEM_SWAD }
        if (IN(2)) grid.sync();
        for (int it_ = bid; it_ < 512 * REP_SSDP; it_ += G_) { const int it = it_ & 511; ITEM_SSDP }
    }
    SEAM(2);
    if (IN(3)) {
        ssd_norm_pass(p);
        late_weights(p, lds);
        __syncthreads();
        EpiProj<1> E{GATES, NG, RS1, nullptr, 0, 0, 0};
        GEMM(EpiProj<1>, E, XB, ws + WS_WIN + (size_t)NA * 2048 * 2, MPAD, NG, 2048, bid);
    }
    SEAM(3);
    if (IN(4)) {
        EpiMerge<0> Ea{MG, GATES};
        GEMM(EpiMerge<0>, Ea, AO, ws + WS_WSWA, MPAD, 2048, 1024, bid);
        EpiMerge<1> Eb{MG, GATES + 4096};
        GEMM(EpiMerge<1>, Eb, MO, ws + WS_WMEM, MPAD, 2048, 1024, bid);
        EpiMerge<1> Ec{MG, GATES + 2048};
        GEMM(EpiMerge<1>, Ec, SO, ws + WS_WSSD, MPAD, 2048, 2048, bid);
    }
    SEAM(4);
    if (IN(5)) {
        EpiWout E{p.in[0], p.in[1], p.out + O_YP, p.out + O_YS, X1B, PART};
        GEMM(EpiWout, E, MG, ws + WS_WOUT, MPAD, 2048, 2048, bid);
    }
    SEAM(5);
    if (IN(6))
_Pragma("nounroll")
    for (int rep_ = 0; rep_ < REP_P6; ++rep_) {
        EpiFfnUp E{PART, ACT};
        GEMM(EpiFfnUp, E, X1B, ws + WS_WGU, MPAD, 2 * DFF, 2048, bid);
    }
    SEAM(6);
    if (IN(7)) {
        EpiDown E{p.out + O_YP, p.out + O_YS};
        GEMM(EpiDown, E, ACT, ws + WS_WD, MPAD, 2048, DFF, bid);
    }
#undef IN
#undef SEAM
}

#ifndef N_LAUNCHES
#define N_LAUNCHES 1
#endif
extern "C" void kernel_launch(void* const* d_in, const int* in_sizes, int n_in, void* d_out, int out_size, void* d_ws, size_t ws_size, hipStream_t stream) {
    static int grid = 0;
    if (grid == 0) {
        if (n_in != 32 || (size_t)out_size != O_END || ws_size < WS_END) { fprintf(stderr, "kernel_launch: unexpected sizes n_in %d out %d ws %zu (need %zu)\n", n_in, out_size, ws_size, (size_t)WS_END); grid = -1; return; }
        int dev = 0, cus = 0, per_cu = 0;
        hipGetDevice(&dev); hipDeviceGetAttribute(&cus, hipDeviceAttributeMultiprocessorCount, dev);
        if (hipFuncSetAttribute((const void*)mega, hipFuncAttributeMaxDynamicSharedMemorySize, LDS_BYTES) != hipSuccess) { fprintf(stderr, "kernel_launch: hipFuncSetAttribute failed\n"); grid = -1; return; }
        if (hipOccupancyMaxActiveBlocksPerMultiprocessor(&per_cu, (const void*)mega, 512, LDS_BYTES) != hipSuccess || per_cu < 1) { fprintf(stderr, "kernel_launch: occupancy query says %d\n", per_cu); per_cu = 1; }
        (void)hipGetLastError();
        grid = cus;
    }
    if (grid < 0) return;
    KP p{};
    for (int i = 0; i < 32; ++i) p.in[i] = (const float*)d_in[i];
    p.out = (float*)d_out; p.ws = (unsigned char*)d_ws;
#if N_LAUNCHES == 1
    p.ph_lo = 0; p.ph_hi = 8;
    void* args[] = {&p};
    hipError_t e = hipLaunchCooperativeKernel((const void*)mega, dim3(grid), dim3(512), args, LDS_BYTES, stream);
    if (e != hipSuccess) fprintf(stderr, "cooperative launch failed: %s (grid %d)\n", hipGetErrorString(e), grid);
#else
    for (int k = 0; k < 8; ++k) { p.ph_lo = k; p.ph_hi = k + 1; hipLaunchKernelGGL(mega, dim3(grid), dim3(512), LDS_BYTES, stream, p); }
#endif
}
```

```cpp
#include <hip/hip_runtime.h>
#include <hip/hip_cooperative_groups.h>
#include <cstdio>
#include <cstdint>
namespace cg = cooperative_groups;
namespace pg8 {
#define PG8_LAS __attribute__((address_space(3)))
typedef unsigned short bf16_t;
typedef short bf16x8 __attribute__((ext_vector_type(8)));
typedef float f32x4 __attribute__((ext_vector_type(4)));
typedef unsigned u32x4 __attribute__((ext_vector_type(4)));
constexpr int BM = 256, BK = 64, HALF = 128, HTB = HALF * BK * 2  , STAGE_BYTES = 8 * HTB, NXCD = 8, WGM = 4;

__host__ __device__ __forceinline__ int lds_byte(int r, int c) { const int st = (r >> 4) * 2 + (c >> 5), rr = r & 15, cc = c & 31, ob = rr * 64 + cc * 2; return st * 1024 + (ob ^ (((ob >> 9) & 1) << 5)); }
__host__ __device__ __forceinline__ void stage_rc(int b, int& R, int& C) { const int st = b / 1024, sb = b % 1024, swz = sb ^ (((sb >> 9) & 1) << 5); R = (st >> 1) * 16 + swz / 64; C = (st & 1) * 32 + (swz % 64) / 2; }
__host__ __device__ __forceinline__ int perm32(int rho) { const int n = rho >> 4, i = rho & 15; return 8 * (i >> 2) + 4 * n + (i & 3); }

struct Unit { int pm, pn; };
struct Gemm { const bf16_t* A; const bf16_t* Bt; int M, N, K; };
struct StaticOrder {
    int nM, nN, nwg, G, c;
    __host__ __device__ void init(int M, int N, int G_, int c_) { nM = M / BM; nN = N / BM; nwg = nM * nN; G = G_; c = c_; }
    __host__ __device__ bool next(int i, Unit& u) const {
        const long L = (long)i * G + c; if (L >= nwg) return false;
        int wgid = (int)L; { const int q = nwg / NXCD, r = nwg % NXCD, xcd = wgid % NXCD, off = wgid / NXCD; wgid = (xcd < r ? xcd * (q + 1) : r * (q + 1) + (xcd - r) * q) + off; }
        const int nig = WGM * nN, gid = wgid / nig, fm = gid * WGM, gsz = (nM - fm) < WGM ? (nM - fm) : WGM;
        u.pm = fm + ((wgid % nig) % gsz); u.pn = (wgid % nig) / gsz; return true;
    }
    __device__ __forceinline__ void a_ready(const Unit&) const {}
    __device__ __forceinline__ void done(const Unit&) const {}
};

__device__ __forceinline__ unsigned cvt_pk_bf16(float lo, float hi) { unsigned r; asm volatile("v_cvt_pk_bf16_f32 %0, %1, %2" : "=v"(r) : "v"(lo), "v"(hi)); return r; }
typedef float f32x2 __attribute__((ext_vector_type(2)));
template <class Epi, class Sched, bool ALIGN_EPI = false, bool SP2 = false>
__device__ __forceinline__ void gemm_phase(PG8_LAS unsigned char* lds, const Gemm g, const Sched& S, const Epi& E) {
    const int tid = threadIdx.x, wid = __builtin_amdgcn_readfirstlane(tid >> 6), lane = tid & 63, wr = wid >> 2, wc = wid & 3, fr = lane & 15, fq = lane >> 4;
    const int K = g.K, nt = K / BK;
    unsigned voffA[2], voffB[2];
#pragma unroll
    for (int i = 0; i < 2; ++i) { int R, C; stage_rc(tid * 16 + i * 8192, R, C); const int Rb = Epi::PERM ? ((R & ~31) + perm32(R & 31)) : R;
        voffA[i] = (unsigned)(R * K + C) * 2u; voffB[i] = (unsigned)(Rb * K + C) * 2u; }
    const size_t kstep = (size_t)(BK * 2);
    const size_t hstep = (size_t)HALF * K * 2;
    const size_t tstep = 2 * hstep;
    const unsigned ldsw = (unsigned)wid * 1024u;
    const int aoff = lds_byte(wr * 64 + fr, fq * 8), boff = lds_byte(wc * 32 + fr, fq * 8);
#define PG8_SA(b, h) (((b) * 2 + (h)) * HTB)
#define PG8_SB(b, h) ((4 + (b) * 2 + (h)) * HTB)
#define PG8_STAGE(bufoff, gbase, voff) do { _Pragma("unroll") for (int _i = 0; _i < 2; ++_i) \
        __builtin_amdgcn_global_load_lds((const unsigned*)((const char*)(gbase) + (voff)[_i]), (PG8_LAS unsigned*)(lds + (bufoff) + ldsw + _i * 8192), 16, 0, 0); } while (0)
#define PG8_LDA(dst, b, h) do { _Pragma("unroll") for (int m = 0; m < 4; ++m) _Pragma("unroll") for (int k = 0; k < 2; ++k) dst[m][k] = *(const PG8_LAS bf16x8*)(lds + PG8_SA(b, h) + aoff + m * 2048 + k * 1024); } while (0)
#define PG8_LDB(dst, b, h) do { _Pragma("unroll") for (int n = 0; n < 2; ++n) _Pragma("unroll") for (int k = 0; k < 2; ++k) dst[n][k] = *(const PG8_LAS bf16x8*)(lds + PG8_SB(b, h) + boff + n * 2048 + k * 1024); } while (0)
#define PG8_MMA(ai, bj, At, Bt) do { __builtin_amdgcn_s_setprio(1); _Pragma("unroll") for (int m = 0; m < 4; ++m) _Pragma("unroll") for (int n = 0; n < 2; ++n) _Pragma("unroll") for (int k = 0; k < 2; ++k) \
        acc[ai][bj][m][n] = __builtin_amdgcn_mfma_f32_16x16x32_bf16(Bt[n][k], At[m][k], acc[ai][bj][m][n], 0, 0, 0); __builtin_amdgcn_s_setprio(0); } while (0)
#define PG8_WAIT_V(n) asm volatile("s_waitcnt vmcnt(" #n ")" ::: "memory")
#define PG8_WAIT_L(n) asm volatile("s_waitcnt lgkmcnt(" #n ")" ::: "memory")
#define PG8_BAR __builtin_amdgcn_s_barrier()
#define PG8_SCHED __builtin_amdgcn_sched_barrier(0)
    Unit cur, nxt; int ui = 0;
    if (!S.next(0, cur)) return;
    f32x4 acc[2][2][4][2];
#pragma unroll
    for (int a = 0; a < 2; ++a)
#pragma unroll
        for (int b = 0; b < 2; ++b)
#pragma unroll
            for (int m = 0; m < 4; ++m)
#pragma unroll
                for (int n = 0; n < 2; ++n) acc[a][b][m][n] = (f32x4){0.f, 0.f, 0.f, 0.f};
    bf16x8 At[4][2], B0[2][2], B1[2][2];
    const char* cA = (const char*)g.A + (size_t)cur.pm * tstep; const char* cB = (const char*)g.Bt + (size_t)cur.pn * tstep;
    S.a_ready(cur);
    if constexpr (SP2) {
        PG8_STAGE(PG8_SB(0, 0), cB, voffB); PG8_STAGE(PG8_SB(0, 1), cB + hstep, voffB); PG8_STAGE(PG8_SA(0, 0), cA, voffA); PG8_STAGE(PG8_SA(0, 1), cA + hstep, voffA);
        if (wr == 1) PG8_BAR;
        PG8_WAIT_V(2); PG8_BAR;
        PG8_STAGE(PG8_SB(1, 0), cB + kstep, voffB); PG8_STAGE(PG8_SA(1, 0), cA + kstep, voffA); PG8_STAGE(PG8_SB(1, 1), cB + hstep + kstep, voffB);
        PG8_WAIT_V(6); PG8_BAR;
    } else {
        PG8_STAGE(PG8_SB(0, 0), cB, voffB); PG8_STAGE(PG8_SA(0, 0), cA, voffA); PG8_STAGE(PG8_SB(0, 1), cB + hstep, voffB); PG8_STAGE(PG8_SA(0, 1), cA + hstep, voffA);
        if (wr == 1) PG8_BAR;
        PG8_WAIT_V(4); PG8_BAR;
        PG8_STAGE(PG8_SB(1, 0), cB + kstep, voffB); PG8_STAGE(PG8_SA(1, 0), cA + kstep, voffA); PG8_STAGE(PG8_SB(1, 1), cB + hstep + kstep, voffB);
        PG8_WAIT_V(6); PG8_BAR;
    }
    for (;;) {
        const bool has_next = S.next(ui + 1, nxt);
        const char* nA = has_next ? (const char*)g.A + (size_t)nxt.pm * tstep : cA; const char* nB = has_next ? (const char*)g.Bt + (size_t)nxt.pn * tstep : cB;
        for (int t = 0; t < nt; t += 2) {
            const bool last = (t == nt - 2);
            const char* a1 = cA + (size_t)(t + 1) * kstep;
            const char* a2 = last ? nA : cA + (size_t)(t + 2) * kstep; const char* b2 = last ? nB : cB + (size_t)(t + 2) * kstep;
            const char* a3 = a2 + kstep; const char* b3 = b2 + kstep;
            if (last && has_next) S.a_ready(nxt);
            if constexpr (SP2) {
            PG8_LDB(B0, 0, 0); PG8_LDB(B1, 0, 1); PG8_SCHED; PG8_LDA(At, 0, 0); PG8_STAGE(PG8_SA(1, 1), a1 + hstep, voffA);
            PG8_WAIT_V(8); PG8_WAIT_L(0); PG8_BAR; PG8_MMA(0, 0, At, B0); PG8_MMA(0, 1, At, B1); PG8_BAR; PG8_SCHED;
            PG8_LDA(At, 0, 1); PG8_STAGE(PG8_SB(0, 0), b2, voffB); PG8_STAGE(PG8_SB(0, 1), b2 + hstep, voffB); PG8_STAGE(PG8_SA(0, 0), a2, voffA);
            PG8_WAIT_V(8); PG8_WAIT_L(0); PG8_BAR; PG8_MMA(1, 0, At, B0); PG8_MMA(1, 1, At, B1); PG8_BAR; PG8_SCHED;
            PG8_LDB(B0, 1, 0); PG8_LDB(B1, 1, 1); PG8_SCHED; PG8_LDA(At, 1, 0); PG8_STAGE(PG8_SA(0, 1), a2 + hstep, voffA);
            PG8_WAIT_V(8); PG8_WAIT_L(0); PG8_BAR; PG8_MMA(0, 0, At, B0); PG8_MMA(0, 1, At, B1); PG8_BAR; PG8_SCHED;
            PG8_LDA(At, 1, 1); PG8_STAGE(PG8_SB(1, 0), b3, voffB); PG8_STAGE(PG8_SB(1, 1), b3 + hstep, voffB); PG8_STAGE(PG8_SA(1, 0), a3, voffA);
            PG8_WAIT_V(8); PG8_WAIT_L(0); PG8_BAR; PG8_MMA(1, 0, At, B0); PG8_MMA(1, 1, At, B1); PG8_BAR; PG8_SCHED;
            } else {
            PG8_LDB(B0, 0, 0); PG8_SCHED; PG8_LDA(At, 0, 0); PG8_STAGE(PG8_SA(1, 1), a1 + hstep, voffA);
            PG8_WAIT_L(8); PG8_BAR; PG8_WAIT_L(0); PG8_MMA(0, 0, At, B0); PG8_BAR; PG8_SCHED;
            PG8_LDB(B1, 0, 1); PG8_STAGE(PG8_SB(0, 0), b2, voffB);
            PG8_BAR; PG8_WAIT_L(0); PG8_MMA(0, 1, At, B1); PG8_BAR;
            PG8_LDA(At, 0, 1); PG8_STAGE(PG8_SA(0, 0), a2, voffA);
            PG8_BAR; PG8_WAIT_L(0); PG8_MMA(1, 0, At, B0); PG8_BAR; PG8_SCHED;
            PG8_STAGE(PG8_SB(0, 1), b2 + hstep, voffB);
            PG8_WAIT_V(6); PG8_BAR; PG8_MMA(1, 1, At, B1); PG8_BAR;
            PG8_LDB(B0, 1, 0); PG8_SCHED; PG8_LDA(At, 1, 0); PG8_STAGE(PG8_SA(0, 1), a2 + hstep, voffA);
            PG8_WAIT_L(8); PG8_BAR; PG8_WAIT_L(0); PG8_MMA(0, 0, At, B0); PG8_BAR; PG8_SCHED;
            PG8_LDB(B1, 1, 1); PG8_STAGE(PG8_SB(1, 0), b3, voffB);
            PG8_BAR; PG8_WAIT_L(0); PG8_MMA(0, 1, At, B1); PG8_BAR;
            PG8_LDA(At, 1, 1); PG8_STAGE(PG8_SA(1, 0), a3, voffA);
            PG8_BAR; PG8_WAIT_L(0); PG8_MMA(1, 0, At, B0); PG8_BAR; PG8_SCHED;
            PG8_STAGE(PG8_SB(1, 1), b3 + hstep, voffB);
            PG8_WAIT_V(6); PG8_BAR; PG8_MMA(1, 1, At, B1); PG8_BAR;
            }
        }
        if constexpr (ALIGN_EPI) { if (wr == 0) PG8_BAR; }
        if constexpr (!Epi::AFTER_DRAIN) { E(acc, cur, wr, wc, fr, fq); S.done(cur); }
        if (!has_next) break;
#pragma unroll
        for (int a = 0; a < 2; ++a)
#pragma unroll
            for (int b = 0; b < 2; ++b)
#pragma unroll
                for (int m = 0; m < 4; ++m)
#pragma unroll
                    for (int n = 0; n < 2; ++n) acc[a][b][m][n] = (f32x4){0.f, 0.f, 0.f, 0.f};
        cur = nxt; cA = nA; cB = nB; ++ui;
        if constexpr (ALIGN_EPI) { if (wr == 1) PG8_BAR; }
    }
    PG8_WAIT_V(0);
    if constexpr (!ALIGN_EPI) { if (wr == 0) PG8_BAR; }
    PG8_BAR;
    if constexpr (Epi::AFTER_DRAIN) { E.fused(acc, cur, wr, wc, fr, fq, lds, wid, lane); S.done(cur); }
#undef PG8_SA
#undef PG8_SB
#undef PG8_STAGE
#undef PG8_LDA
#undef PG8_LDB
#undef PG8_MMA
#undef PG8_WAIT_V
#undef PG8_WAIT_L
#undef PG8_BAR
#undef PG8_SCHED
}
}

#ifndef PG8_SP2
#define PG8_SP2 true
#endif
#ifndef PG8_ALIGN
#define PG8_ALIGN true
#endif

#define LAS __attribute__((address_space(3)))
typedef unsigned short bf16;
typedef short bf16x8 __attribute__((ext_vector_type(8)));
typedef float f32x4 __attribute__((ext_vector_type(4)));
typedef unsigned v4u __attribute__((ext_vector_type(4)));
typedef unsigned v2u __attribute__((ext_vector_type(2)));

constexpr int DM = 2048, SEQ = 2048, NBATCH = 16, MP = NBATCH * SEQ, MS = 128, MTOK = MP + MS, MPAD = 33024;
constexpr int NA = 7936, NG = 6144, NIN = 14080, DFF = 5632, CONVCH = 3072;
constexpr int CQ = 0, CK = 1024, CV = 1280, CZ = 1536, CXBC = 3584, CDT = 6656, CQM = 6912;
constexpr float EPS = 1e-6f;
constexpr int LDS_BYTES = 147456;

constexpr size_t O_YP = 0, O_YS = O_YP + (size_t)MP * DM, O_PK = O_YS + (size_t)MS * DM, O_PV = O_PK + 524288, O_PMK = O_PV + 524288, O_PMV = O_PMK + 4194304,
                 O_PSSM = O_PMV + 4194304, O_PCONV = O_PSSM + 4194304, O_SK = O_PCONV + 147456, O_SV = O_SK + 4194304, O_SSSM = O_SV + 4194304, O_SCONV = O_SSSM + 33554432,
                 O_END = O_SCONV + 1179648;
constexpr size_t WS_WIN = 0, WS_WM = WS_WIN + (size_t)NIN * 2048 * 2, WS_WSWA = WS_WM + 2048u * 2048 * 2, WS_WSSD = WS_WSWA + 2048u * 1024 * 2, WS_WMEM = WS_WSSD + 2048u * 2048 * 2,
                 WS_WOUT = WS_WMEM + 2048u * 1024 * 2, WS_WGU = WS_WOUT + 2048u * 2048 * 2, WS_WD = WS_WGU + (size_t)2 * DFF * 2048 * 2, WS_XB = WS_WD + (size_t)2048 * DFF * 2,
                 WS_MB = WS_XB + (size_t)MPAD * 2048 * 2, WS_MKV = WS_MB + 4096u * 2048 * 2, WS_BIG = WS_MKV + 4096u * 2048 * 2, WS_MO = WS_BIG + (size_t)MPAD * NA * 2,
                 WS_DT = WS_MO + (size_t)MPAD * 1024 * 2, WS_SSQ = WS_DT + (size_t)MPAD * 32 * 4, WS_RS1 = WS_SSQ + (size_t)MPAD * 32 * 4, WS_RSM = WS_RS1 + (size_t)MPAD * 4,
                 WS_PART = WS_RSM + 4096u * 4, WS_TS = WS_PART + (size_t)MPAD * 32 * 4, WS_PARTS = WS_TS + 256, WS_BAR = WS_PARTS + 128 * 64 * 4, WS_XCX = WS_BAR + 16384, WS_END = WS_XCX + (size_t)MPAD * 2048 * 2;
constexpr size_t WS_XCBC = WS_WGU;
static_assert((size_t)MP * 1024 * 2 <= WS_XB - WS_WGU, "XCbc fits");
static_assert(WS_END <= 1073741824u, "workspace budget");
constexpr size_t BIG_ACT = 0, BIG_X1B = (size_t)MPAD * DFF * 2;
static_assert(BIG_X1B + (size_t)MPAD * 2048 * 2 <= (size_t)MPAD * NA * 2, "big overlay");
constexpr size_t YP_AO = 0, YP_SO = (size_t)MPAD * 1024 * 2;
static_assert(YP_SO + (size_t)MPAD * 2048 * 2 <= (size_t)MP * DM * 4, "AO/SO fit in y_prompt");

struct KP { const float* in[32]; float* out; unsigned char* ws; int ph_lo, ph_hi; };

__device__ __forceinline__ float bf2f(unsigned v) { return __uint_as_float(v << 16); }
typedef float f32x2_t __attribute__((ext_vector_type(2))); typedef __bf16 bf16x2_t __attribute__((ext_vector_type(2)));
__device__ __forceinline__ unsigned pk2(float lo, float hi) { const f32x2_t v = {lo, hi}; const bf16x2_t b = __builtin_convertvector(v, bf16x2_t); return __builtin_bit_cast(unsigned, b); }
__device__ __forceinline__ unsigned f2bf(float f) { return pk2(f, f) & 0xffffu; }
__device__ __forceinline__ float lo16(unsigned w) { return __uint_as_float(w << 16); }
__device__ __forceinline__ float hi16(unsigned w) { return __uint_as_float(w & 0xffff0000u); }
__device__ __forceinline__ float sigmoidf_(float x) { return __builtin_amdgcn_rcpf(1.0f + __expf(-x)); }
__device__ __forceinline__ float siluf_(float x) { return x * __builtin_amdgcn_rcpf(1.0f + __expf(-x)); }
__device__ __forceinline__ float wave_sum(float v) {
#pragma unroll
    for (int o = 1; o < 64; o <<= 1) v += __shfl_xor(v, o);
    return v;
}
__device__ __forceinline__ float wave_max(float v) {
#pragma unroll
    for (int o = 1; o < 64; o <<= 1) v = fmaxf(v, __shfl_xor(v, o));
    return v;
}
__device__ __forceinline__ f32x4 mfma16(bf16x8 a, bf16x8 b, f32x4 c) { return __builtin_amdgcn_mfma_f32_16x16x32_bf16(a, b, c, 0, 0, 0); }
#define LBAR() asm volatile("s_waitcnt lgkmcnt(0)\n\ts_barrier" ::: "memory")
#define UNPACK8(W_, F_) do { F_[0] = lo16((W_)[0]); F_[1] = hi16((W_)[0]); F_[2] = lo16((W_)[1]); F_[3] = hi16((W_)[1]); F_[4] = lo16((W_)[2]); F_[5] = hi16((W_)[2]); F_[6] = lo16((W_)[3]); F_[7] = hi16((W_)[3]); } while (0)

template <int ACT> struct EpiProj {
    static constexpr bool PERM = true, AFTER_DRAIN = false;
    bf16* O; int ldc; const float* rs; float* f32o; int fc0, fw, fld; int tiled;
    __device__ __forceinline__ void operator()(const pg8::f32x4 (&acc)[2][2][4][2], const pg8::Unit& u, int wr, int wc, int fr, int fq) const {
#pragma unroll
        for (int ai = 0; ai < 2; ++ai)
#pragma unroll
            for (int m = 0; m < 4; ++m) {
                const int row = u.pm * 256 + ai * 128 + wr * 64 + m * 16 + fr; const float s = rs[row];
#pragma unroll
                for (int bj = 0; bj < 2; ++bj) {
                    const int col = u.pn * 256 + bj * 128 + wc * 32 + 8 * fq;
                    f32x4 v0 = acc[ai][bj][m][0] * s, v1 = acc[ai][bj][m][1] * s;
                    if (ACT == 1) { v0[0] = sigmoidf_(v0[0]); v0[1] = sigmoidf_(v0[1]); v0[2] = sigmoidf_(v0[2]); v0[3] = sigmoidf_(v0[3]);
                                    v1[0] = sigmoidf_(v1[0]); v1[1] = sigmoidf_(v1[1]); v1[2] = sigmoidf_(v1[2]); v1[3] = sigmoidf_(v1[3]); }
                    v4u w; w.x = pk2(v0[0], v0[1]); w.y = pk2(v0[2], v0[3]); w.z = pk2(v1[0], v1[1]); w.w = pk2(v1[2], v1[3]);
                    if (tiled) *(v4u*)(O + (((size_t)(u.pn * tiled + u.pm)) << 16) + (ai * 128 + wr * 64 + m * 16 + fr) * 256 + bj * 128 + wc * 32 + 8 * fq) = w;
                    else *(v4u*)(O + (size_t)row * ldc + col) = w;
                    if (f32o && col >= fc0 && col < fc0 + fw) { float* d = f32o + (size_t)row * fld + (col - fc0); *(f32x4*)d = v0; *(f32x4*)(d + 4) = v1; }
                }
            }
    }
};
template <int ACCUM> struct EpiMerge {
    static constexpr bool PERM = true, AFTER_DRAIN = false;
    bf16* MG; const bf16* G;
    __device__ __forceinline__ void operator()(const pg8::f32x4 (&acc)[2][2][4][2], const pg8::Unit& u, int wr, int wc, int fr, int fq) const {
#pragma unroll
        for (int ai = 0; ai < 2; ++ai)
#pragma unroll
            for (int m = 0; m < 4; ++m) {
                const int row = u.pm * 256 + ai * 128 + wr * 64 + m * 16 + fr;
#pragma unroll
                for (int bj = 0; bj < 2; ++bj) {
                    const int col = u.pn * 256 + bj * 128 + wc * 32 + 8 * fq;
                    const v4u gw = *(const v4u*)(G + (((size_t)(u.pn * 128 + u.pm)) << 16) + (ai * 128 + wr * 64 + m * 16 + fr) * 256 + bj * 128 + wc * 32 + 8 * fq);
                    float g[8]; UNPACK8(gw, g);
                    const f32x4 a0 = acc[ai][bj][m][0], a1 = acc[ai][bj][m][1];
                    float v[8] = {g[0] * a0[0], g[1] * a0[1], g[2] * a0[2], g[3] * a0[3], g[4] * a1[0], g[5] * a1[1], g[6] * a1[2], g[7] * a1[3]};
                    bf16* dst = MG + (size_t)row * 2048 + col;
                    if (ACCUM) { const v4u ow = *(const v4u*)dst; float o[8]; UNPACK8(ow, o);
#pragma unroll
                        for (int e = 0; e < 8; ++e) v[e] += o[e]; }
                    v4u w; w.x = pk2(v[0], v[1]); w.y = pk2(v[2], v[3]); w.z = pk2(v[4], v[5]); w.w = pk2(v[6], v[7]);
                    *(v4u*)dst = w;
                }
            }
    }
};
struct EpiWout {
    static constexpr bool PERM = true, AFTER_DRAIN = false;
    const bf16* XBp; bf16* X1B; float* part;
    __device__ __forceinline__ void operator()(const pg8::f32x4 (&acc)[2][2][4][2], const pg8::Unit& u, int wr, int wc, int fr, int fq) const {
#pragma unroll
        for (int ai = 0; ai < 2; ++ai)
#pragma unroll
            for (int m = 0; m < 4; ++m) {
                const int row = u.pm * 256 + ai * 128 + wr * 64 + m * 16 + fr;
                float ps = 0.f;
#pragma unroll
                for (int bj = 0; bj < 2; ++bj) {
                    const int col = u.pn * 256 + bj * 128 + wc * 32 + 8 * fq;
                    f32x4 v0 = {0.f, 0.f, 0.f, 0.f}, v1 = {0.f, 0.f, 0.f, 0.f};
                    { const v4u xw = *(const v4u*)(XBp + (size_t)row * DM + col); float xf[8]; UNPACK8(xw, xf);
                      v0 = (f32x4){xf[0], xf[1], xf[2], xf[3]} + acc[ai][bj][m][0]; v1 = (f32x4){xf[4], xf[5], xf[6], xf[7]} + acc[ai][bj][m][1]; }
                    v4u w; w.x = pk2(v0[0], v0[1]); w.y = pk2(v0[2], v0[3]); w.z = pk2(v1[0], v1[1]); w.w = pk2(v1[2], v1[3]);
                    *(v4u*)(X1B + (size_t)row * DM + col) = w;
                    ps += (v0[0] * v0[0] + v0[1] * v0[1]) + (v0[2] * v0[2] + v0[3] * v0[3]) + (v1[0] * v1[0] + v1[1] * v1[1]) + (v1[2] * v1[2] + v1[3] * v1[3]);
                }
                ps += __shfl_xor(ps, 16); ps += __shfl_xor(ps, 32);
                if (fq == 0) part[(size_t)row * 32 + u.pn * 4 + wc] = ps;
            }
    }
};
struct EpiFfnUp {
    static constexpr bool PERM = true, AFTER_DRAIN = false;
    const float* part; bf16* ACT;
    __device__ __forceinline__ void operator()(const pg8::f32x4 (&acc)[2][2][4][2], const pg8::Unit& u, int wr, int wc, int fr, int fq) const {
#pragma unroll
        for (int ai = 0; ai < 2; ++ai)
#pragma unroll
            for (int m = 0; m < 4; ++m) {
                const int row = u.pm * 256 + ai * 128 + wr * 64 + m * 16 + fr;
                const f32x4* pp = (const f32x4*)(part + (size_t)row * 32 + fq * 8);
                const f32x4 t0 = pp[0], t1 = pp[1];
                float ss = ((t0[0] + t0[1]) + (t0[2] + t0[3])) + ((t1[0] + t1[1]) + (t1[2] + t1[3]));
                ss += __shfl_xor(ss, 16); ss += __shfl_xor(ss, 32);
                const float rs = rsqrtf(ss * (1.0f / DM) + EPS);
                const f32x4 g0 = acc[ai][0][m][0] * rs, g1 = acc[ai][0][m][1] * rs, u0 = acc[ai][1][m][0] * rs, u1 = acc[ai][1][m][1] * rs;
                v4u w; w.x = pk2(siluf_(g0[0]) * u0[0], siluf_(g0[1]) * u0[1]); w.y = pk2(siluf_(g0[2]) * u0[2], siluf_(g0[3]) * u0[3]);
                w.z = pk2(siluf_(g1[0]) * u1[0], siluf_(g1[1]) * u1[1]); w.w = pk2(siluf_(g1[2]) * u1[2], siluf_(g1[3]) * u1[3]);
                *(v4u*)(ACT + (size_t)row * DFF + u.pn * 128 + wc * 32 + 8 * fq) = w;
            }
    }
};
struct EpiDown {
    static constexpr bool PERM = true, AFTER_DRAIN = false;
    float* yp; float* ys; const bf16* X1B;
    __device__ __forceinline__ void operator()(const pg8::f32x4 (&acc)[2][2][4][2], const pg8::Unit& u, int wr, int wc, int fr, int fq) const {
#pragma unroll
        for (int ai = 0; ai < 2; ++ai)
#pragma unroll
            for (int m = 0; m < 4; ++m) {
                const int row = u.pm * 256 + ai * 128 + wr * 64 + m * 16 + fr;
                if (row < MTOK) {
                    float* yr = row < MP ? yp + (size_t)row * DM : ys + (size_t)(row - MP) * DM;
#pragma unroll
                    for (int bj = 0; bj < 2; ++bj) {
                        const int col = u.pn * 256 + bj * 128 + wc * 32 + 8 * fq;
                        const v4u xw = *(const v4u*)(X1B + (size_t)row * DM + col); float xf[8]; UNPACK8(xw, xf);
                        __builtin_nontemporal_store((f32x4){xf[0], xf[1], xf[2], xf[3]} + acc[ai][bj][m][0], (f32x4*)(yr + col));
                        __builtin_nontemporal_store((f32x4){xf[4], xf[5], xf[6], xf[7]} + acc[ai][bj][m][1], (f32x4*)(yr + col + 4));
                    }
                }
            }
    }
};

__device__ __forceinline__ int maprow(int mode, int n0) {
    if (mode == 1) return n0 < 6688 ? n0 : n0 + 224;
    if (mode == 2) return (n0 >> 7) * 256 + (n0 & 127);
    if (mode == 3) return (n0 >> 7) * 256 + 128 + (n0 & 127);
    return n0;
}
__device__ __forceinline__ void tr_item(const float* W, int K, int N, bf16* WT, const float* gain, int mode, LAS float* scr, int item, int lane) {
    const int nblk = N / 32, kb = item / nblk, nb = item % nblk, k0 = 64 * kb, n0 = 32 * nb;
#pragma unroll 8
    for (int i = 0; i < 32; ++i) { const int kk = 2 * i + (lane >> 5); float v = W[(size_t)(k0 + kk) * N + n0 + (lane & 31)]; if (gain) v *= gain[k0 + kk]; scr[kk * 33 + (lane & 31)] = v; }
    asm volatile("s_waitcnt lgkmcnt(0)" ::: "memory");
    const int c = lane & 7, d0 = maprow(mode, n0);
#pragma unroll
    for (int j = 0; j < 4; ++j) { const int n = (lane >> 3) + 8 * j; const LAS float* s = scr + (8 * c) * 33 + n;
        v4u o; o.x = pk2(s[0 * 33], s[1 * 33]); o.y = pk2(s[2 * 33], s[3 * 33]); o.z = pk2(s[4 * 33], s[5 * 33]); o.w = pk2(s[6 * 33], s[7 * 33]);
        *(v4u*)(WT + (size_t)(d0 + n) * K + k0 + 8 * c) = o; }
    asm volatile("s_waitcnt lgkmcnt(0)" ::: "memory");
}
__device__ __forceinline__ void tr_item64(const float* W, int K, int N, bf16* WT, const float* gain, int mode, LAS float* scr, int item, int lane) {
    const int nblk = (N + 63) / 64, kb = item / nblk, nb = item % nblk, k0 = 64 * kb, n0 = 64 * nb;
    const int c4 = (lane & 15) * 4; const bool colok = n0 + c4 < N;
#pragma unroll 8
    for (int i = 0; i < 16; ++i) { const int kk = 4 * i + (lane >> 4);
        f32x4 v = {0.f, 0.f, 0.f, 0.f}; if (colok) v = *(const f32x4*)(W + (size_t)(k0 + kk) * N + n0 + c4);
        if (gain) v = v * gain[k0 + kk];
        scr[kk * 65 + c4] = v[0]; scr[kk * 65 + c4 + 1] = v[1]; scr[kk * 65 + c4 + 2] = v[2]; scr[kk * 65 + c4 + 3] = v[3]; }
    asm volatile("s_waitcnt lgkmcnt(0)" ::: "memory");
    const int c = lane & 7, d0a = maprow(mode, n0), d0b = maprow(mode, n0 + 32);
#pragma unroll
    for (int j = 0; j < 8; ++j) { const int n = (lane >> 3) + 8 * j; const LAS float* s = scr + (8 * c) * 65 + n;
        if (n0 + n < N) { v4u o; o.x = pk2(s[0 * 65], s[1 * 65]); o.y = pk2(s[2 * 65], s[3 * 65]); o.z = pk2(s[4 * 65], s[5 * 65]); o.w = pk2(s[6 * 65], s[7 * 65]);
            const int drow = n < 32 ? d0a + n : d0b + (n - 32);
            *(v4u*)(WT + (size_t)drow * K + k0 + 8 * c) = o; } }
    asm volatile("s_waitcnt lgkmcnt(0)" ::: "memory");
}
__device__ __forceinline__ void row_to_bf16(const float* xrow, bf16* orow, float* rs, int lane) {
    f32x4 v[8]; float s = 0.f;
#pragma unroll
    for (int j = 0; j < 8; ++j) { v[j] = *((const f32x4*)xrow + lane + 64 * j); s += (v[j][0] * v[j][0] + v[j][1] * v[j][1]) + (v[j][2] * v[j][2] + v[j][3] * v[j][3]); }
    s = wave_sum(s);
    if (lane == 0) *rs = rsqrtf(s * (1.0f / DM) + EPS);
#pragma unroll
    for (int j = 0; j < 8; ++j) { v2u w; w.x = pk2(v[j][0], v[j][1]); w.y = pk2(v[j][2], v[j][3]); *((v2u*)orow + lane + 64 * j) = w; }
}
__device__ __forceinline__ void prologue(const KP& p, LAS unsigned char* lds) {
    const int tid = threadIdx.x, lane = tid & 63, wave = tid >> 6;
    const int gw = blockIdx.x * 8 + wave, NGW = gridDim.x * 8;
    unsigned char* ws = p.ws;
    LAS float* scr = (LAS float*)(lds + wave * 16640);
    constexpr int I_IN = 32 * 217, I_M = 32 * 32, I_S = 16 * 32;
    constexpr int NITEMS = I_IN + I_M + I_S + I_M + I_S + I_M;
    for (int it = gw; it < NITEMS; it += NGW) {
        int r = it;
        if (r < I_IN) { tr_item64(p.in[10], 2048, 13856, (bf16*)(ws + WS_WIN), p.in[9], 1, scr, r, lane); continue; } r -= I_IN;
        if (r < I_M) { tr_item64(p.in[21], 2048, 2048, (bf16*)(ws + WS_WM), p.in[20], 0, scr, r, lane); continue; } r -= I_M;
        if (r < I_S) { tr_item64(p.in[24], 1024, 2048, (bf16*)(ws + WS_WSWA), nullptr, 0, scr, r, lane); continue; } r -= I_S;
        if (r < I_M) { tr_item64(p.in[25], 2048, 2048, (bf16*)(ws + WS_WSSD), p.in[19], 0, scr, r, lane); continue; } r -= I_M;
        if (r < I_S) { tr_item64(p.in[26], 1024, 2048, (bf16*)(ws + WS_WMEM), nullptr, 0, scr, r, lane); continue; } r -= I_S;
        tr_item64(p.in[27], 2048, 2048, (bf16*)(ws + WS_WOUT), nullptr, 0, scr, r, lane);
    }
    { v4u* z = (v4u*)((bf16*)(ws + WS_WIN) + (size_t)6688 * 2048); const int nz = 224 * 2048 / 8; const v4u zero = {0u, 0u, 0u, 0u};
      for (int i = blockIdx.x * 512 + tid; i < nz; i += gridDim.x * 512) z[i] = zero; }
    bf16* XB = (bf16*)(ws + WS_XB); float* RS1 = (float*)(ws + WS_RS1);
    for (int r = gw; r < MTOK; r += 2 * NGW) {
        const int r2 = r + NGW; const bool two = r2 < MTOK;
        const float* s0 = r < MP ? p.in[0] + (size_t)r * DM : p.in[1] + (size_t)(r - MP) * DM;
        const float* s1 = two ? (r2 < MP ? p.in[0] + (size_t)r2 * DM : p.in[1] + (size_t)(r2 - MP) * DM) : s0;
        f32x4 v0[8], v1[8]; float q0 = 0.f, q1 = 0.f;
#pragma unroll
        for (int j = 0; j < 8; ++j) { v0[j] = *((const f32x4*)s0 + lane + 64 * j); v1[j] = *((const f32x4*)s1 + lane + 64 * j); }
#pragma unroll
        for (int j = 0; j < 8; ++j) { q0 += (v0[j][0] * v0[j][0] + v0[j][1] * v0[j][1]) + (v0[j][2] * v0[j][2] + v0[j][3] * v0[j][3]); q1 += (v1[j][0] * v1[j][0] + v1[j][1] * v1[j][1]) + (v1[j][2] * v1[j][2] + v1[j][3] * v1[j][3]); }
        q0 = wave_sum(q0); q1 = wave_sum(q1);
        if (lane == 0) { RS1[r] = rsqrtf(q0 * (1.0f / DM) + EPS); if (two) RS1[r2] = rsqrtf(q1 * (1.0f / DM) + EPS); }
#pragma unroll
        for (int j = 0; j < 8; ++j) { v2u w0; w0.x = pk2(v0[j][0], v0[j][1]); w0.y = pk2(v0[j][2], v0[j][3]); *((v2u*)(XB + (size_t)r * DM) + lane + 64 * j) = w0;
            if (two) { v2u w1; w1.x = pk2(v1[j][0], v1[j][1]); w1.y = pk2(v1[j][2], v1[j][3]); *((v2u*)(XB + (size_t)r2 * DM) + lane + 64 * j) = w1; } }
    }
    bf16* MB = (bf16*)(ws + WS_MB); float* RSM = (float*)(ws + WS_RSM);
    for (int r = gw; r < 4096; r += NGW) row_to_bf16(p.in[8] + (size_t)r * DM, MB + (size_t)r * DM, RSM + r, lane);
}

__device__ __forceinline__ void late_weights(const KP& p, LAS unsigned char* lds) {
    const int tid = threadIdx.x, lane = tid & 63, wave = tid >> 6;
    const int gw = blockIdx.x * 8 + wave, NGW = gridDim.x * 8;
    unsigned char* ws = p.ws;
    LAS float* scr = (LAS float*)(lds + wave * 16640);
    constexpr int I_G = 32 * 88, I_D = 88 * 32;
    for (int it = gw; it < 2 * I_G + I_D; it += NGW) {
        int r = it;
        if (r < I_G) { tr_item64(p.in[29], 2048, DFF, (bf16*)(ws + WS_WGU), p.in[28], 2, scr, r, lane); continue; } r -= I_G;
        if (r < I_G) { tr_item64(p.in[30], 2048, DFF, (bf16*)(ws + WS_WGU), p.in[28], 3, scr, r, lane); continue; } r -= I_G;
        tr_item64(p.in[31], DFF, 2048, (bf16*)(ws + WS_WD), nullptr, 0, scr, r, lane);
    }
}
__device__ __forceinline__ void conv_prepass(const KP& p) {
    const bf16* PA = (const bf16*)(p.ws + WS_BIG);
    bf16* XCx = (bf16*)(p.ws + WS_XCX); bf16* XCbc = (bf16*)(p.ws + WS_XCBC);
    const int gthreads = gridDim.x * 512;
    for (int task = blockIdx.x * 512 + threadIdx.x; task < NBATCH * 64 * 384; task += gthreads) {
        const int cgp = task % 384, strip = (task / 384) & 63, b = task / (384 * 64);
        const int ch0 = cgp * 8;
        float cw0[8], cw1[8], cw2[8], cw3[8], cbv[8];
#pragma unroll
        for (int e = 0; e < 8; ++e) { cw0[e] = p.in[14][ch0 + e]; cw1[e] = p.in[14][CONVCH + ch0 + e]; cw2[e] = p.in[14][2 * CONVCH + ch0 + e]; cw3[e] = p.in[14][3 * CONVCH + ch0 + e]; cbv[e] = p.in[15][ch0 + e]; }
        const bf16* src = PA + (size_t)(b * SEQ) * NA + CXBC + ch0;
        bf16* dst = ch0 < 2048 ? XCx + (size_t)(b * SEQ) * 2048 + ch0 : XCbc + (size_t)(b * SEQ) * 1024 + (ch0 - 2048);
        const int ldd = ch0 < 2048 ? 2048 : 1024;
        const int t0 = strip * 32;
        float r0[8], r1[8], r2[8];
        {   v4u z0 = {0u, 0u, 0u, 0u}, z1 = z0, z2 = z0;
            if (t0 > 0) { z0 = *(const v4u*)(src + (size_t)(t0 - 3) * NA); z1 = *(const v4u*)(src + (size_t)(t0 - 2) * NA); z2 = *(const v4u*)(src + (size_t)(t0 - 1) * NA); }
            UNPACK8(z0, r0); UNPACK8(z1, r1); UNPACK8(z2, r2); }
#pragma unroll 8
        for (int l = 0; l < 32; ++l) {
            const v4u zc = *(const v4u*)(src + (size_t)(t0 + l) * NA);
            float cur[8], ov[8]; UNPACK8(zc, cur);
#pragma unroll
            for (int e = 0; e < 8; ++e) { const float v = cw0[e] * r0[e] + cw1[e] * r1[e] + cw2[e] * r2[e] + cw3[e] * cur[e] + cbv[e]; ov[e] = siluf_(v); r0[e] = r1[e]; r1[e] = r2[e]; r2[e] = cur[e]; }
            v4u o; o.x = pk2(ov[0], ov[1]); o.y = pk2(ov[2], ov[3]); o.z = pk2(ov[4], ov[5]); o.w = pk2(ov[6], ov[7]);
            *(v4u*)(dst + (size_t)(t0 + l) * ldd) = o;
        }
        if (strip == 63) {
            float* d = p.out + O_PCONV + (size_t)(b * 3) * CONVCH + ch0;
            *(f32x4*)d = (f32x4){r0[0], r0[1], r0[2], r0[3]}; *(f32x4*)(d + 4) = (f32x4){r0[4], r0[5], r0[6], r0[7]};
            *(f32x4*)(d + CONVCH) = (f32x4){r1[0], r1[1], r1[2], r1[3]}; *(f32x4*)(d + CONVCH + 4) = (f32x4){r1[4], r1[5], r1[6], r1[7]};
            *(f32x4*)(d + 2 * CONVCH) = (f32x4){r2[0], r2[1], r2[2], r2[3]}; *(f32x4*)(d + 2 * CONVCH + 4) = (f32x4){r2[4], r2[5], r2[6], r2[7]};
        }
    }
}

#define LDSP(T, off) ((LAS T*)(lds + (off)))
typedef short v4i16_t __attribute__((ext_vector_type(4)));
__device__ __forceinline__ bf16x8 tr_frag(LAS bf16* a0, LAS bf16* a1) {
    const v4i16_t lo = __builtin_amdgcn_ds_read_tr16_b64_v4i16((LAS v4i16_t*)a0), hi = __builtin_amdgcn_ds_read_tr16_b64_v4i16((LAS v4i16_t*)a1);
    bf16x8 r; r[0] = lo[0]; r[1] = lo[1]; r[2] = lo[2]; r[3] = lo[3]; r[4] = hi[0]; r[5] = hi[1]; r[6] = hi[2]; r[7] = hi[3]; return r;
}

__device__ __forceinline__ void swa_prompt_all(const KP& p, LAS unsigned char* lds, int first, int stride, int nitems) {
    const int tid = threadIdx.x, lane = tid & 63, w = tid >> 6, fr = lane & 15, fq = lane >> 4;
    LAS bf16* Qs = LDSP(bf16, 0);
    LAS bf16* Ks = LDSP(bf16, 18432);
    LAS bf16* Vs = LDSP(bf16, 57600);
    LAS bf16* Ps = LDSP(bf16, 96768) + w * (16 * 168);
    const bf16* PA = (const bf16*)(p.ws + WS_BIG);
    bf16* AO = (bf16*)((unsigned char*)(p.out + O_YP) + YP_AO);
    const int c = tid >> 1, half = tid & 1, qr = tid >> 2, qd = tid & 3;
    float kwv[32], qwv[16];
#pragma unroll
    for (int e = 0; e < 32; ++e) kwv[e] = p.in[12][half * 32 + e];
#pragma unroll
    for (int e = 0; e < 16; ++e) qwv[e] = p.in[11][qd * 16 + e] * 0.125f;
    v4u kz[4], vz[4], qz[2];
#define SWA_LOAD_KV(it_) do { const int kvh_ = (it_) & 3, blk_ = ((it_) >> 2) & 15, b_ = (it_) >> 6, s_ = (blk_ - 1) * 128 + c; \
        if (s_ >= 0) { const bf16* src_ = PA + (size_t)(b_ * SEQ + s_) * NA + kvh_ * 64 + half * 32; \
            _Pragma("unroll") for (int i = 0; i < 4; ++i) { kz[i] = *(const v4u*)(src_ + CK + i * 8); vz[i] = *(const v4u*)(src_ + CV + i * 8); } } \
        else { _Pragma("unroll") for (int i = 0; i < 4; ++i) { kz[i] = (v4u){0u, 0u, 0u, 0u}; vz[i] = (v4u){0u, 0u, 0u, 0u}; } } } while (0)
#define SWA_LOAD_Q(it_, hq_) do { const int kvh_ = (it_) & 3, blk_ = ((it_) >> 2) & 15, b_ = (it_) >> 6; \
        const bf16* qs_ = PA + (size_t)(b_ * SEQ + blk_ * 128 + qr) * NA + CQ + (kvh_ * 4 + (hq_)) * 64 + qd * 16; qz[0] = *(const v4u*)qs_; qz[1] = *(const v4u*)(qs_ + 8); } while (0)
    if (first < nitems) { SWA_LOAD_KV(first); SWA_LOAD_Q(first, 0); }
    for (int item = first; item < nitems; item += stride) {
      const int kvh = item & 3, blk = (item >> 2) & 15, b = item >> 6;
_Pragma("nounroll")
      for (int hq = 0; hq < 4; ++hq) {
        const int h = kvh * 4 + hq;
        if (hq == 0) {
            float kf[32];
#pragma unroll
            for (int i = 0; i < 4; ++i) { float t[8]; UNPACK8(kz[i], t);
#pragma unroll
                for (int e = 0; e < 8; ++e) kf[i * 8 + e] = t[e]; }
            float ss = 0.f;
#pragma unroll
            for (int e = 0; e < 32; ++e) ss += kf[e] * kf[e];
            ss += __shfl_xor(ss, 1);
            const float rs = rsqrtf(ss * (1.0f / 64.0f) + EPS);
#pragma unroll
            for (int e = 0; e < 32; ++e) kf[e] = kf[e] * rs * kwv[e];
#pragma unroll
            for (int i = 0; i < 4; ++i) { v4u o; o.x = pk2(kf[i * 8 + 0], kf[i * 8 + 1]); o.y = pk2(kf[i * 8 + 2], kf[i * 8 + 3]); o.z = pk2(kf[i * 8 + 4], kf[i * 8 + 5]); o.w = pk2(kf[i * 8 + 6], kf[i * 8 + 7]);
                *(LAS v4u*)(Ks + c * 72 + half * 32 + i * 8) = o; }
#pragma unroll
            for (int i = 0; i < 4; ++i) *(LAS v4u*)(Vs + c * 72 + half * 32 + i * 8) = vz[i];
            if (blk == 15 && c >= 128) {
                float* dk = p.out + O_PK + ((size_t)(b * 128 + (c - 128)) * 4 + kvh) * 64 + half * 32;
                float* dv = p.out + O_PV + ((size_t)(b * 128 + (c - 128)) * 4 + kvh) * 64 + half * 32;
#pragma unroll
                for (int i = 0; i < 4; ++i) { float t[8]; UNPACK8(vz[i], t);
                    *(f32x4*)(dk + i * 8) = (f32x4){kf[i * 8], kf[i * 8 + 1], kf[i * 8 + 2], kf[i * 8 + 3]}; *(f32x4*)(dk + i * 8 + 4) = (f32x4){kf[i * 8 + 4], kf[i * 8 + 5], kf[i * 8 + 6], kf[i * 8 + 7]};
                    *(f32x4*)(dv + i * 8) = (f32x4){t[0], t[1], t[2], t[3]}; *(f32x4*)(dv + i * 8 + 4) = (f32x4){t[4], t[5], t[6], t[7]}; }
            }
        }
        if (hq == 0) {
            if (tid < 144) *(LAS v4u*)(Ks + 256 * 72 + tid * 8) = (v4u){0u, 0u, 0u, 0u};
            if (tid >= 256 && tid < 400) *(LAS v4u*)(Vs + 256 * 72 + (tid - 256) * 8) = (v4u){0u, 0u, 0u, 0u};
            if (item + stride < nitems) SWA_LOAD_KV(item + stride);
        }
        {
            float qf[16]; { float t[8]; UNPACK8(qz[0], t);
#pragma unroll
                for (int e = 0; e < 8; ++e) qf[e] = t[e];
                UNPACK8(qz[1], t);
#pragma unroll
                for (int e = 0; e < 8; ++e) qf[8 + e] = t[e]; }
            float ss = 0.f;
#pragma unroll
            for (int e = 0; e < 16; ++e) ss += qf[e] * qf[e];
            ss += __shfl_xor(ss, 1); ss += __shfl_xor(ss, 2);
            const float rs = rsqrtf(ss * (1.0f / 64.0f) + EPS);
#pragma unroll
            for (int e = 0; e < 16; ++e) qf[e] = qf[e] * rs * qwv[e];
            v4u o0, o1; o0.x = pk2(qf[0], qf[1]); o0.y = pk2(qf[2], qf[3]); o0.z = pk2(qf[4], qf[5]); o0.w = pk2(qf[6], qf[7]);
            o1.x = pk2(qf[8], qf[9]); o1.y = pk2(qf[10], qf[11]); o1.z = pk2(qf[12], qf[13]); o1.w = pk2(qf[14], qf[15]);
            *(LAS v4u*)(Qs + qr * 72 + qd * 16) = o0; *(LAS v4u*)(Qs + qr * 72 + qd * 16 + 8) = o1;
        }
        if (hq < 3) SWA_LOAD_Q(item, hq + 1); else if (item + stride < nitems) SWA_LOAD_Q(item + stride, 0);
        LBAR();
        bf16x8 aq[2];
#pragma unroll
        for (int ks = 0; ks < 2; ++ks) aq[ks] = *(LAS bf16x8*)(Qs + (16 * w + fr) * 72 + ks * 32 + fq * 8);
        f32x4 sc[9];
#pragma unroll
        for (int i = 0; i < 9; ++i) { sc[i] = (f32x4){0.f, 0.f, 0.f, 0.f};
#pragma unroll
            for (int ks = 0; ks < 2; ++ks) { const bf16x8 bk = *(LAS bf16x8*)(Ks + ((w + i) * 16 + fr) * 72 + ks * 32 + fq * 8); sc[i] = mfma16(aq[ks], bk, sc[i]); } }
        const float slope = exp2f(-0.5f * (float)(h + 1)), sink = p.in[13][h];
#pragma unroll
        for (int j = 0; j < 4; ++j) {
            const int d = 4 * fq + j - fr; const float sd = slope * (float)d; const bool le0 = d <= 0, ge0 = d >= 0;
            float mx = -INFINITY;
#pragma unroll
            for (int i = 0; i < 9; ++i) { bool ok = (w + i <= 15) && (blk > 0 || w + i >= 8);
                if (i == 0) ok = ok && le0; if (i == 8) ok = ok && ge0;
                const float v = ok ? sc[i][j] - (slope * (float)(128 - 16 * i) + sd) : -INFINITY; sc[i][j] = v; mx = fmaxf(mx, v); }
            mx = fmaxf(mx, __shfl_xor(mx, 1)); mx = fmaxf(mx, __shfl_xor(mx, 2)); mx = fmaxf(mx, __shfl_xor(mx, 4)); mx = fmaxf(mx, __shfl_xor(mx, 8));
            mx = fmaxf(mx, sink);
            float sum = 0.f;
#pragma unroll
            for (int i = 0; i < 9; ++i) { const float e2 = __expf(sc[i][j] - mx); sc[i][j] = e2; sum += e2; }
            sum += __shfl_xor(sum, 1); sum += __shfl_xor(sum, 2); sum += __shfl_xor(sum, 4); sum += __shfl_xor(sum, 8);
            const float inv = 1.0f / (sum + __expf(sink - mx));
#pragma unroll
            for (int i = 0; i < 9; ++i) Ps[(fq * 4 + j) * 168 + i * 16 + fr] = (bf16)f2bf(sc[i][j] * inv);
            Ps[(fq * 4 + j) * 168 + 9 * 16 + fr] = (bf16)0;
        }
        asm volatile("s_waitcnt lgkmcnt(0)" ::: "memory");
        f32x4 o[4];
#pragma unroll
        for (int nt = 0; nt < 4; ++nt) o[nt] = (f32x4){0.f, 0.f, 0.f, 0.f};
#pragma unroll
        for (int ks = 0; ks < 5; ++ks) { const bf16x8 a = *(LAS bf16x8*)(Ps + fr * 168 + ks * 32 + fq * 8);
            LAS bf16* tb = Vs + (w * 16 + ks * 32 + fq * 8 + (fr >> 2)) * 72 + (fr & 3) * 4;
#pragma unroll
            for (int nt = 0; nt < 4; ++nt) { const bf16x8 bv = tr_frag(tb + nt * 16, tb + 4 * 72 + nt * 16); o[nt] = mfma16(a, bv, o[nt]); } }
#pragma unroll
        for (int j = 0; j < 4; ++j) { bf16* dst = AO + (size_t)(b * SEQ + blk * 128 + 16 * w + fq * 4 + j) * 1024 + h * 64 + fr;
#pragma unroll
            for (int nt = 0; nt < 4; ++nt) dst[nt * 16] = (bf16)f2bf(o[nt][j]); }
        LBAR();
      }
    }
#undef SWA_LOAD_KV
#undef SWA_LOAD_Q
}

__device__ __forceinline__ void mem_prompt_item(const KP& p, LAS unsigned char* lds, int item) {
    const int tid = threadIdx.x, lane = tid & 63, w = tid >> 6, fr = lane & 15, fq = lane >> 4;
    const int qt = item & 15, h = (item >> 4) & 3, b = item >> 6;
    LAS bf16* Qc = LDSP(bf16, 0);
    LAS bf16* Kc = LDSP(bf16, 18432);
    LAS bf16* Vs = LDSP(bf16, 0);
    LAS float* rq = LDSP(float, 122880); LAS float* rk = LDSP(float, 123392);
    const bf16* PA = (const bf16*)(p.ws + WS_BIG);
    const bf16* MKV = (const bf16*)(p.ws + WS_MKV);
    bf16* MO = (bf16*)(p.ws + WS_MO);
    const float* qw = p.in[22];
    float ssq_q = 0.f;
    f32x4 sc[16];
#pragma unroll
    for (int i = 0; i < 16; ++i) sc[i] = (f32x4){0.f, 0.f, 0.f, 0.f};
    const bf16* qsrc = PA + (size_t)(b * SEQ + qt * 128 + (tid >> 2)) * NA + CQM + h * 256 + (tid & 3) * 16;
    const bf16* ksrc = MKV + (size_t)(b * 256 + (tid >> 1)) * 2048 + h * 256 + (tid & 1) * 32;
    v4u pq[2], pkv[4];
    pq[0] = *(const v4u*)qsrc; pq[1] = *(const v4u*)(qsrc + 8);
#pragma unroll
    for (int i = 0; i < 4; ++i) pkv[i] = *(const v4u*)(ksrc + i * 8);
    for (int dc = 0; dc < 4; ++dc) {
        {   const int r = tid >> 2, qd = tid & 3;
            float qf[16]; { float t[8]; UNPACK8(pq[0], t);
#pragma unroll
                for (int e = 0; e < 8; ++e) qf[e] = t[e];
                UNPACK8(pq[1], t);
#pragma unroll
                for (int e = 0; e < 8; ++e) qf[8 + e] = t[e]; }
            { const f32x4 g0 = *(const f32x4*)(qw + dc * 64 + qd * 16), g1 = *(const f32x4*)(qw + dc * 64 + qd * 16 + 4), g2 = *(const f32x4*)(qw + dc * 64 + qd * 16 + 8), g3 = *(const f32x4*)(qw + dc * 64 + qd * 16 + 12);
              const float gq[16] = {g0[0], g0[1], g0[2], g0[3], g1[0], g1[1], g1[2], g1[3], g2[0], g2[1], g2[2], g2[3], g3[0], g3[1], g3[2], g3[3]};
#pragma unroll
              for (int e = 0; e < 16; ++e) { ssq_q += qf[e] * qf[e]; qf[e] *= gq[e]; } }
            v4u o0, o1; o0.x = pk2(qf[0], qf[1]); o0.y = pk2(qf[2], qf[3]); o0.z = pk2(qf[4], qf[5]); o0.w = pk2(qf[6], qf[7]);
            o1.x = pk2(qf[8], qf[9]); o1.y = pk2(qf[10], qf[11]); o1.z = pk2(qf[12], qf[13]); o1.w = pk2(qf[14], qf[15]);
            *(LAS v4u*)(Qc + r * 72 + qd * 16) = o0; *(LAS v4u*)(Qc + r * 72 + qd * 16 + 8) = o1;
        }
        {   const int c = tid >> 1, half = tid & 1;
#pragma unroll
            for (int i = 0; i < 4; ++i) *(LAS v4u*)(Kc + c * 72 + half * 32 + i * 8) = pkv[i];
        }
        if (dc < 3) { pq[0] = *(const v4u*)(qsrc + (dc + 1) * 64); pq[1] = *(const v4u*)(qsrc + (dc + 1) * 64 + 8);
#pragma unroll
            for (int i = 0; i < 4; ++i) pkv[i] = *(const v4u*)(ksrc + (dc + 1) * 64 + i * 8); }
        else {
#pragma unroll
            for (int i = 0; i < 4; ++i) pkv[i] = *(const v4u*)(ksrc + 1024 + i * 8); }
        LBAR();
        bf16x8 aq[2];
#pragma unroll
        for (int ks = 0; ks < 2; ++ks) aq[ks] = *(LAS bf16x8*)(Qc + (16 * w + fr) * 72 + ks * 32 + fq * 8);
#pragma unroll
        for (int i = 0; i < 16; ++i)
#pragma unroll
            for (int ks = 0; ks < 2; ++ks) { const bf16x8 bk = *(LAS bf16x8*)(Kc + (i * 16 + fr) * 72 + ks * 32 + fq * 8); sc[i] = mfma16(bk, aq[ks], sc[i]); }
        LBAR();
    }
    ssq_q += __shfl_xor(ssq_q, 1); ssq_q += __shfl_xor(ssq_q, 2);
    if ((tid & 3) == 0) rq[tid >> 2] = rsqrtf(ssq_q * (1.0f / 256.0f) + EPS);
    LBAR();
    bf16x8 aw[8];
    {
        const float rqv = rq[16 * w + fr] * 0.0625f;
        float mx = -INFINITY;
#pragma unroll
        for (int i = 0; i < 16; ++i)
#pragma unroll
            for (int j = 0; j < 4; ++j) { const float v = sc[i][j] * rqv; sc[i][j] = v; mx = fmaxf(mx, v); }
        mx = fmaxf(mx, __shfl_xor(mx, 16)); mx = fmaxf(mx, __shfl_xor(mx, 32));
        float sum = 0.f;
#pragma unroll
        for (int i = 0; i < 16; ++i)
#pragma unroll
            for (int j = 0; j < 4; ++j) { const float e2 = __expf(sc[i][j] - mx); sc[i][j] = e2; sum += e2; }
        sum += __shfl_xor(sum, 16); sum += __shfl_xor(sum, 32);
        const float inv = 1.0f / sum;
#pragma unroll
        for (int ks = 0; ks < 8; ++ks) { v4u wp; wp.x = pk2(sc[2 * ks][0] * inv, sc[2 * ks][1] * inv); wp.y = pk2(sc[2 * ks][2] * inv, sc[2 * ks][3] * inv);
            wp.z = pk2(sc[2 * ks + 1][0] * inv, sc[2 * ks + 1][1] * inv); wp.w = pk2(sc[2 * ks + 1][2] * inv, sc[2 * ks + 1][3] * inv);
            aw[ks] = __builtin_bit_cast(bf16x8, wp); }
    }
    for (int dc = 0; dc < 4; ++dc) {
        {   const int c = tid >> 1, half = tid & 1;
#pragma unroll
            for (int i = 0; i < 4; ++i) *(LAS v4u*)(Vs + c * 72 + half * 32 + i * 8) = pkv[i];
            if (dc < 3) {
#pragma unroll
                for (int i = 0; i < 4; ++i) pkv[i] = *(const v4u*)(ksrc + 1024 + (dc + 1) * 64 + i * 8); }
        }
        LBAR();
        f32x4 o[4];
#pragma unroll
        for (int nt = 0; nt < 4; ++nt) o[nt] = (f32x4){0.f, 0.f, 0.f, 0.f};
#pragma unroll
        for (int ks = 0; ks < 8; ++ks) {
            LAS bf16* tb = Vs + (ks * 32 + fq * 4 + (fr >> 2)) * 72 + (fr & 3) * 4;
#pragma unroll
            for (int nt = 0; nt < 4; ++nt) { const bf16x8 bv = tr_frag(tb + nt * 16, tb + 16 * 72 + nt * 16); o[nt] = mfma16(aw[ks], bv, o[nt]); } }
#pragma unroll
        for (int j = 0; j < 4; ++j) { bf16* dst = MO + (size_t)(b * SEQ + qt * 128 + 16 * w + fq * 4 + j) * 1024 + h * 256 + dc * 64 + fr;
#pragma unroll
            for (int nt = 0; nt < 4; ++nt) dst[nt * 16] = (bf16)f2bf(o[nt][j]); }
        LBAR();
    }
}

__device__ __forceinline__ void memk_norm_pass(const KP& p) {
    const int lane = threadIdx.x & 63, gw = blockIdx.x * 8 + (threadIdx.x >> 6), NGW = gridDim.x * 8;
    bf16* MKV = (bf16*)(p.ws + WS_MKV);
    const f32x4 g = *(const f32x4*)(p.in[23] + lane * 4);
    for (int sg = gw; sg < 4096 * 4; sg += NGW) { const int row = sg >> 2, h = sg & 3;
        v2u* kp = (v2u*)(MKV + (size_t)row * 2048 + h * 256 + lane * 4);
        const v2u kz = *kp; const float k0 = lo16(kz.x), k1 = hi16(kz.x), k2 = lo16(kz.y), k3 = hi16(kz.y);
        const float rs = rsqrtf(wave_sum((k0 * k0 + k1 * k1) + (k2 * k2 + k3 * k3)) * (1.0f / 256.0f) + EPS);
        const f32x4 kn = {k0 * rs * g[0], k1 * rs * g[1], k2 * rs * g[2], k3 * rs * g[3]};
        v2u o; o.x = pk2(kn[0], kn[1]); o.y = pk2(kn[2], kn[3]); *kp = o;
        *(f32x4*)(p.out + O_PMK + (size_t)row * 1024 + h * 256 + lane * 4) = kn; }
}

__device__ __forceinline__ float softplusf_(float x) { return x > 20.f ? x : log1pf(__expf(x)); }
__device__ __forceinline__ void ssd_prompt_item(const KP& p, LAS unsigned char* lds, int b, int head) {
    const int tid = threadIdx.x, lane = tid & 63, w = tid >> 6, fr = lane & 15, fq = lane >> 4;
    const int g = head >> 3;
    const int rt = w < 4 ? w : 11 - w;
    LAS bf16* Xs = LDSP(bf16, 0);
    LAS bf16* Bs = LDSP(bf16, 18432);
    LAS bf16* Cs = LDSP(bf16, 53248);
    LAS bf16* HsT = LDSP(bf16, 88064);
    LAS float* dtv = LDSP(float, 106496); LAS float* acs = LDSP(float, 107008); LAS float* das = LDSP(float, 107520); LAS float* coefv = LDSP(float, 108032);
    const bf16* PA = (const bf16*)(p.ws + WS_BIG);
    const bf16* XCx = (const bf16*)(p.ws + WS_XCX); const bf16* XCbc = (const bf16*)(p.ws + WS_XCBC);
    const float* DT = (const float*)(p.ws + WS_DT);
    float* SSQ = (float*)(p.ws + WS_SSQ);
    bf16* SO = (bf16*)((unsigned char*)(p.out + O_YP) + YP_SO);
    const float dtb = p.in[16][head], Aneg = -__expf(p.in[17][head]), Dh = p.in[18][head];
    f32x4 hst[4];
#pragma unroll
    for (int i = 0; i < 4; ++i) hst[i] = (f32x4){0.f, 0.f, 0.f, 0.f};
    const int pt = w & 3, nb0 = (w >> 2) * 4;
    const int tq = fr >> 2, tp = (fr & 3) * 4;
    const bf16* srcB = XCbc + (size_t)(b * SEQ + (tid >> 4)) * 1024 + g * 128 + (tid & 15) * 8;
    const bf16* srcX = XCx + (size_t)(b * SEQ + (tid >> 3)) * 2048 + head * 64 + (tid & 7) * 8;
    v4u pfB[4], pfC[4], pfX[2]; float pfdt = 0.f;
#pragma unroll
    for (int i = 0; i < 4; ++i) { pfB[i] = *(const v4u*)(srcB + (size_t)(32 * i) * 1024); pfC[i] = *(const v4u*)(srcB + (size_t)(32 * i) * 1024 + 512); }
#pragma unroll
    for (int i = 0; i < 2; ++i) pfX[i] = *(const v4u*)(srcX + (size_t)(64 * i) * 2048);
    if (tid < 128) pfdt = DT[(size_t)(b * SEQ + tid) * 32 + head];
    for (int c = 0; c < 16; ++c) {
        const int t0 = c * 128;
#pragma unroll
        for (int i = 0; i < 4; ++i) { *(LAS v4u*)(Bs + ((tid >> 4) + 32 * i) * 136 + (tid & 15) * 8) = pfB[i]; *(LAS v4u*)(Cs + ((tid >> 4) + 32 * i) * 136 + (tid & 15) * 8) = pfC[i]; }
#pragma unroll
        for (int i = 0; i < 2; ++i) *(LAS v4u*)(Xs + ((tid >> 3) + 64 * i) * 72 + (tid & 7) * 8) = pfX[i];
        if (tid < 128) { const float dt = softplusf_(pfdt + dtb); dtv[tid] = dt; das[tid] = dt * Aneg; }
#pragma unroll
        for (int i = 0; i < 4; ++i) { v2u hw; hw.x = pk2(hst[i][0], hst[i][1]); hw.y = pk2(hst[i][2], hst[i][3]);
            *(LAS v2u*)(HsT + ((nb0 + i) * 16 + fr) * 72 + pt * 16 + fq * 4) = hw; }
        unsigned short zr[16];
#pragma unroll
        for (int j = 0; j < 4; ++j)
#pragma unroll
            for (int nt = 0; nt < 4; ++nt) zr[j * 4 + nt] = PA[(size_t)(b * SEQ + t0 + 16 * rt + fq * 4 + j) * NA + CZ + head * 64 + nt * 16 + fr];
        if (c < 15) {
#pragma unroll
            for (int i = 0; i < 4; ++i) { pfB[i] = *(const v4u*)(srcB + (size_t)(t0 + 128 + 32 * i) * 1024); pfC[i] = *(const v4u*)(srcB + (size_t)(t0 + 128 + 32 * i) * 1024 + 512); }
#pragma unroll
            for (int i = 0; i < 2; ++i) pfX[i] = *(const v4u*)(srcX + (size_t)(t0 + 128 + 64 * i) * 2048);
            if (tid < 128) pfdt = DT[(size_t)(b * SEQ + t0 + 128 + tid) * 32 + head];
        }
        LBAR();
        {
            const float a0 = das[2 * lane], a1 = das[2 * lane + 1]; float s = a0 + a1;
#pragma unroll
            for (int off = 1; off < 64; off <<= 1) { const float t = __shfl_up(s, off); if (lane >= off) s += t; }
            acs[2 * lane + 1] = s; acs[2 * lane] = s - a1;
            const float tot = __shfl(s, 63); coefv[2 * lane] = __expf(tot - (s - a1)) * dtv[2 * lane]; coefv[2 * lane + 1] = __expf(tot - s) * dtv[2 * lane + 1]; }
        asm volatile("s_waitcnt lgkmcnt(0)" ::: "memory");
        bf16x8 ac[4];
#pragma unroll
        for (int ks = 0; ks < 4; ++ks) ac[ks] = *(LAS bf16x8*)(Cs + (16 * rt + fr) * 136 + ks * 32 + fq * 8);
        f32x4 yo[4], yd[4];
#pragma unroll
        for (int nt = 0; nt < 4; ++nt) { yo[nt] = (f32x4){0.f, 0.f, 0.f, 0.f}; yd[nt] = (f32x4){0.f, 0.f, 0.f, 0.f}; }
#pragma unroll
        for (int ks = 0; ks < 4; ++ks) { LAS bf16* hb = HsT + (ks * 32 + fq * 8 + tq) * 72 + tp;
#pragma unroll
            for (int nt = 0; nt < 4; ++nt) { const bf16x8 bh = tr_frag(hb + nt * 16, hb + 4 * 72 + nt * 16); yo[nt] = mfma16(ac[ks], bh, yo[nt]); } }
        const float alc = acs[16 * rt + fr];
#pragma unroll
        for (int ks = 0; ks < 4; ++ks) {
            if (2 * ks <= rt) {
                v4u wp = {0u, 0u, 0u, 0u};
#pragma unroll
                for (int hf = 0; hf < 2; ++hf) { const int nt = 2 * ks + hf;
                    if (nt <= rt) {
                        f32x4 cb = {0.f, 0.f, 0.f, 0.f};
#pragma unroll
                        for (int kk = 0; kk < 4; ++kk) { const bf16x8 bb = *(LAS bf16x8*)(Bs + (nt * 16 + fr) * 136 + kk * 32 + fq * 8); cb = mfma16(bb, ac[kk], cb); }
                        const f32x4 as4 = *(LAS f32x4*)(acs + nt * 16 + fq * 4), dt4 = *(LAS f32x4*)(dtv + nt * 16 + fq * 4);
                        float wv[4];
#pragma unroll
                        for (int j = 0; j < 4; ++j) { const bool keep = nt < rt || fq * 4 + j <= fr; wv[j] = keep ? cb[j] * __expf(alc - as4[j]) * dt4[j] : 0.f; }
                        if (hf == 0) { wp.x = pk2(wv[0], wv[1]); wp.y = pk2(wv[2], wv[3]); } else { wp.z = pk2(wv[0], wv[1]); wp.w = pk2(wv[2], wv[3]); }
                    }
                }
                const bf16x8 aw = __builtin_bit_cast(bf16x8, wp);
                LAS bf16* xb0 = Xs + (ks * 32 + fq * 4 + tq) * 72 + tp;
#pragma unroll
                for (int nt = 0; nt < 4; ++nt) { const bf16x8 bx = tr_frag(xb0 + nt * 16, xb0 + 16 * 72 + nt * 16); yd[nt] = mfma16(aw, bx, yd[nt]); }
            }
        }
        float al[4];
#pragma unroll
        for (int j = 0; j < 4; ++j) al[j] = acs[16 * rt + fq * 4 + j];
#pragma unroll
        for (int j = 0; j < 4; ++j) {
            const int l = 16 * rt + fq * 4 + j; const size_t tok = (size_t)(b * SEQ + t0 + l); const float el = __expf(al[j]);
            float ss = 0.f;
#pragma unroll
            for (int nt = 0; nt < 4; ++nt) { const int pp = nt * 16 + fr; const float xv = bf2f(Xs[l * 72 + pp]);
                const float y = yd[nt][j] + el * yo[nt][j] + Dh * xv;
                const float zv = bf2f(zr[j * 4 + nt]);
                const float yz = y * siluf_(zv); ss += yz * yz; SO[tok * 2048 + head * 64 + pp] = (bf16)f2bf(yz); }
            ss += __shfl_xor(ss, 1); ss += __shfl_xor(ss, 2); ss += __shfl_xor(ss, 4); ss += __shfl_xor(ss, 8);
            if (fr == 0) SSQ[tok * 32 + head] = ss;
        }
        const float aL = acs[127];
        f32x4 st[4];
#pragma unroll
        for (int i = 0; i < 4; ++i) st[i] = (f32x4){0.f, 0.f, 0.f, 0.f};
#pragma unroll
        for (int ks = 0; ks < 4; ++ks) {
            LAS bf16* xa = Xs + (ks * 32 + fq * 8 + tq) * 72 + pt * 16 + tp;
            const bf16x8 axr = tr_frag(xa, xa + 4 * 72);
            const v4u axw = __builtin_bit_cast(v4u, axr);
            float xf[8]; UNPACK8(axw, xf);
            { const f32x4 c0 = *(LAS f32x4*)(coefv + ks * 32 + fq * 8), c1 = *(LAS f32x4*)(coefv + ks * 32 + fq * 8 + 4);
              xf[0] *= c0[0]; xf[1] *= c0[1]; xf[2] *= c0[2]; xf[3] *= c0[3]; xf[4] *= c1[0]; xf[5] *= c1[1]; xf[6] *= c1[2]; xf[7] *= c1[3]; }
            v4u pw; pw.x = pk2(xf[0], xf[1]); pw.y = pk2(xf[2], xf[3]); pw.z = pk2(xf[4], xf[5]); pw.w = pk2(xf[6], xf[7]);
            const bf16x8 ax = __builtin_bit_cast(bf16x8, pw);
            LAS bf16* tb = Bs + (ks * 32 + fq * 8 + tq) * 136 + tp;
#pragma unroll
            for (int i = 0; i < 4; ++i) { const bf16x8 bb = tr_frag(tb + (nb0 + i) * 16, tb + 4 * 136 + (nb0 + i) * 16); st[i] = mfma16(ax, bb, st[i]); }
        }
        const float eL = __expf(aL);
#pragma unroll
        for (int i = 0; i < 4; ++i) hst[i] = hst[i] * eL + st[i];
        LBAR();
    }
#pragma unroll
    for (int i = 0; i < 4; ++i)
#pragma unroll
        for (int j = 0; j < 4; ++j) p.out[O_PSSM + ((size_t)(b * 32 + head) * 64 + pt * 16 + fq * 4 + j) * 128 + (nb0 + i) * 16 + fr] = hst[i][j];
}
template <int NB> __device__ __forceinline__ void skinny_core(LAS unsigned char* lds, const bf16* A, const bf16* Bt, const int (&brow)[NB], int K, f32x4 (&out)[NB]) {
    const int lane = threadIdx.x & 63, w = threadIdx.x >> 6, fr = lane & 15, fq = lane >> 4;
    const int ksw = K >> 8;
    const bf16* ap = A + (size_t)fr * K + (size_t)w * ksw * 32 + fq * 8;
    const bf16* bp[NB];
    f32x4 acc[8][NB];
#pragma unroll
    for (int nb = 0; nb < NB; ++nb) { bp[nb] = Bt + (size_t)(brow[nb] + fr) * K + (size_t)w * ksw * 32 + fq * 8;
#pragma unroll
        for (int rt = 0; rt < 8; ++rt) acc[rt][nb] = (f32x4){0.f, 0.f, 0.f, 0.f}; }
#pragma unroll 2
    for (int s = 0; s < ksw; ++s) {
        bf16x8 bfr[NB];
#pragma unroll
        for (int nb = 0; nb < NB; ++nb) bfr[nb] = *(const bf16x8*)(bp[nb] + s * 32);
#pragma unroll
        for (int rt = 0; rt < 8; ++rt) { const bf16x8 a = *(const bf16x8*)(ap + (size_t)(rt * 16) * K + s * 32);
#pragma unroll
            for (int nb = 0; nb < NB; ++nb) acc[rt][nb] = mfma16(a, bfr[nb], acc[rt][nb]); }
    }
    LAS f32x4* red = (LAS f32x4*)lds;
#pragma unroll
    for (int rt = 0; rt < 8; ++rt)
#pragma unroll
        for (int nb = 0; nb < NB; ++nb) red[((w * 8 + rt) * NB + nb) * 64 + lane] = acc[rt][nb];
    LBAR();
#pragma unroll
    for (int nb = 0; nb < NB; ++nb) { f32x4 s = red[((0 * 8 + w) * NB + nb) * 64 + lane];
#pragma unroll
        for (int w2 = 1; w2 < 8; ++w2) s += red[((w2 * 8 + w) * NB + nb) * 64 + lane];
        out[nb] = s; }
    LBAR();
}
#define SK_ROWCOL const int lane_ = threadIdx.x & 63, w_ = threadIdx.x >> 6, fr_ = lane_ & 15, fq_ = lane_ >> 4
template <int ACT> __device__ __forceinline__ void skinny_proj(LAS unsigned char* lds, const bf16* A, const bf16* Bt, int N, int K, bf16* O, int ldc, const float* rs, float* f32o, int fc0, int fw, int fld) {
    SK_ROWCOL;
    for (int u = blockIdx.x; u < N / 32; u += gridDim.x) {
        const int br[2] = {u * 32, u * 32 + 16}; f32x4 acc[2];
        skinny_core<2>(lds, A, Bt, br, K, acc);
#pragma unroll
        for (int j = 0; j < 4; ++j) { const int row = MP + 16 * w_ + 4 * fq_ + j; const float s = rs[row];
#pragma unroll
            for (int nt = 0; nt < 2; ++nt) { const int col = u * 32 + nt * 16 + fr_; float v = acc[nt][j] * s; if (ACT == 1) v = sigmoidf_(v);
                O[(size_t)row * ldc + col] = (bf16)f2bf(v);
                if (f32o && col >= fc0 && col < fc0 + fw) f32o[(size_t)row * fld + col - fc0] = v; } }
    }
}
template <int ACCUM> __device__ __forceinline__ void skinny_merge(LAS unsigned char* lds, const bf16* A, const bf16* Bt, int K, bf16* MG, const bf16* G) {
    SK_ROWCOL;
    for (int u = blockIdx.x; u < 2048 / 16; u += gridDim.x) {
        const int br[1] = {u * 16}; f32x4 acc[1];
        skinny_core<1>(lds, A, Bt, br, K, acc);
#pragma unroll
        for (int j = 0; j < 4; ++j) { const int row = MP + 16 * w_ + 4 * fq_ + j, col = u * 16 + fr_;
            float v = bf2f(G[(size_t)row * NG + col]) * acc[0][j];
            if (ACCUM) v += bf2f(MG[(size_t)row * 2048 + col]);
            MG[(size_t)row * 2048 + col] = (bf16)f2bf(v); }
    }
}
__device__ __forceinline__ void skinny_wout(LAS unsigned char* lds, const bf16* A, const bf16* Bt, const float* xs, bf16* X1B, float* parts) {
    SK_ROWCOL;
    for (int u = blockIdx.x; u < 2048 / 32; u += gridDim.x) {
        const int br[2] = {u * 32, u * 32 + 16}; f32x4 acc[2];
        skinny_core<2>(lds, A, Bt, br, 2048, acc);
#pragma unroll
        for (int j = 0; j < 4; ++j) { const int r = 16 * w_ + 4 * fq_ + j; float ps = 0.f;
#pragma unroll
            for (int nt = 0; nt < 2; ++nt) { const int col = u * 32 + nt * 16 + fr_; const float v = xs[(size_t)r * DM + col] + acc[nt][j];
                X1B[(size_t)(MP + r) * DM + col] = (bf16)f2bf(v); ps += v * v; }
            ps += __shfl_xor(ps, 1); ps += __shfl_xor(ps, 2); ps += __shfl_xor(ps, 4); ps += __shfl_xor(ps, 8);
            if (fr_ == 0) parts[r * 64 + u] = ps; }
    }
}
__device__ __forceinline__ void skinny_ffn_up(LAS unsigned char* lds, const bf16* A, const bf16* Bt, const float* parts, bf16* ACT) {
    SK_ROWCOL;
    LAS float* rs2s = (LAS float*)(lds + 131072);
    if (threadIdx.x < 128) { const f32x4* pp = (const f32x4*)(parts + threadIdx.x * 64); float ss = 0.f;
#pragma unroll
        for (int i = 0; i < 16; ++i) { const f32x4 t = pp[i]; ss += (t[0] + t[1]) + (t[2] + t[3]); }
        rs2s[threadIdx.x] = rsqrtf(ss * (1.0f / DM) + EPS); }
    LBAR();
    for (int u = blockIdx.x; u < DFF / 16; u += gridDim.x) {
        const int j0 = u * 16, gr = (j0 >> 7) * 256 + (j0 & 127);
        const int br[2] = {gr, gr + 128}; f32x4 acc[2];
        skinny_core<2>(lds, A, Bt, br, 2048, acc);
#pragma unroll
        for (int j = 0; j < 4; ++j) { const int r = 16 * w_ + 4 * fq_ + j; const float rs = rs2s[r];
            ACT[(size_t)(MP + r) * DFF + j0 + fr_] = (bf16)f2bf(siluf_(acc[0][j] * rs) * (acc[1][j] * rs)); }
    }
}
__device__ __forceinline__ void skinny_down(LAS unsigned char* lds, const bf16* A, const bf16* Bt, float* ys, const bf16* X1B) {
    SK_ROWCOL;
    for (int u = blockIdx.x; u < 2048 / 16; u += gridDim.x) {
        const int br[1] = {u * 16}; f32x4 acc[1];
        skinny_core<1>(lds, A, Bt, br, DFF, acc);
#pragma unroll
        for (int j = 0; j < 4; ++j) { const int r = 16 * w_ + 4 * fq_ + j, col = u * 16 + fr_; ys[(size_t)r * DM + col] = bf2f(X1B[(size_t)(MP + r) * DM + col]) + acc[0][j]; }
    }
}

__device__ __forceinline__ void ssd_decode_item(const KP& p, LAS unsigned char* lds, int item) {
    const int tid = threadIdx.x, lane = tid & 63;
    const int head = item & 31, b = item >> 5, g = head >> 3;
    const size_t tok = (size_t)(MP + b);
    LAS float* xs = LDSP(float, 0); LAS float* Bv = LDSP(float, 256); LAS float* Cv = LDSP(float, 768); LAS float* red = LDSP(float, 1280);
    const bf16* PA = (const bf16*)(p.ws + WS_BIG);
    const float* DT = (const float*)(p.ws + WS_DT);
    float* SSQ = (float*)(p.ws + WS_SSQ);
    bf16* SO = (bf16*)((unsigned char*)(p.out + O_YP) + YP_SO);
    const int pp = tid >> 3, q = tid & 7;
    const size_t hoff = ((size_t)(b * 32 + head) * 64 + pp) * 128;
    f32x4 hv[4];
#pragma unroll
    for (int i = 0; i < 4; ++i) hv[i] = *(const f32x4*)(p.in[6] + hoff + q * 4 + 32 * i);
    const float dtraw = DT[tok * 32 + head];
    const unsigned short zraw = PA[tok * NA + CZ + head * 64 + pp];
    if (tid < 320) {
        const int ch = tid < 64 ? head * 64 + tid : (tid < 192 ? 2048 + g * 128 + (tid - 64) : 2560 + g * 128 + (tid - 192));
        const float raw = bf2f(PA[tok * NA + CXBC + ch]);
        const float s0 = p.in[7][(size_t)(b * 3 + 0) * CONVCH + ch], s1 = p.in[7][(size_t)(b * 3 + 1) * CONVCH + ch], s2 = p.in[7][(size_t)(b * 3 + 2) * CONVCH + ch];
        const float v = p.in[14][ch] * s0 + p.in[14][CONVCH + ch] * s1 + p.in[14][2 * CONVCH + ch] * s2 + p.in[14][3 * CONVCH + ch] * raw + p.in[15][ch];
        const float o = siluf_(v);
        if (tid < 64) xs[tid] = o; else if (tid < 192) Bv[tid - 64] = o; else Cv[tid - 192] = o;
        if (tid < 64 || (head & 7) == 0) { float* d = p.out + O_SCONV + (size_t)(b * 3) * CONVCH + ch; d[0] = s1; d[CONVCH] = s2; d[2 * CONVCH] = raw; }
    }
    LBAR();
    const float dt = softplusf_(dtraw + p.in[16][head]);
    const float dA = __expf(dt * (-__expf(p.in[17][head]))), Dh = p.in[18][head];
    const float xv = xs[pp], xdt = xv * dt;
    float part = 0.f, cbp = 0.f;
#pragma unroll
    for (int i = 0; i < 4; ++i) {
        const int n = q * 4 + 32 * i;
        const f32x4 bv = *(LAS f32x4*)(Bv + n), cv = *(LAS f32x4*)(Cv + n);
        part += (cv[0] * hv[i][0] + cv[1] * hv[i][1]) + (cv[2] * hv[i][2] + cv[3] * hv[i][3]);
        cbp += (cv[0] * bv[0] + cv[1] * bv[1]) + (cv[2] * bv[2] + cv[3] * bv[3]);
        __builtin_nontemporal_store(hv[i] * dA + bv * xdt, (f32x4*)(p.out + O_SSSM + hoff + n));
    }
    part += __shfl_xor(part, 1); part += __shfl_xor(part, 2); part += __shfl_xor(part, 4);
    cbp += __shfl_xor(cbp, 1); cbp += __shfl_xor(cbp, 2); cbp += __shfl_xor(cbp, 4);
    if (q == 0) {
        const float y = cbp * dt * xv + part * dA + Dh * xv;
        const float zv = bf2f(zraw);
        const float yz = y * siluf_(zv);
        SO[tok * 2048 + head * 64 + pp] = (bf16)f2bf(yz);
        red[pp] = yz * yz;
    }
    LBAR();
    if (tid < 64) { const float s = wave_sum(red[lane]); if (lane == 0) SSQ[tok * 32 + head] = s; }
    LBAR();
}

__device__ __forceinline__ void swa_decode_item(const KP& p, LAS unsigned char* lds, int item) {
    const int tid = threadIdx.x, lane = tid & 63, w = tid >> 6;
    const int kvh = item & 3, b = item >> 2;
    const size_t tok = (size_t)(MP + b);
    LAS float* Kf = LDSP(float, 0);
    LAS float* Vf = LDSP(float, 33792);
    LAS float* qn = LDSP(float, 66816);
    LAS float* sc = LDSP(float, 67840);
    const bf16* PA = (const bf16*)(p.ws + WS_BIG);
    bf16* AO = (bf16*)((unsigned char*)(p.out + O_YP) + YP_AO);
    for (int idx = tid; idx < 128 * 16; idx += 512) { const int j = idx >> 4, c4 = idx & 15;
        const size_t off = ((size_t)(b * 128 + j) * 4 + kvh) * 64 + c4 * 4;
        const f32x4 kv = *(const f32x4*)(p.in[2] + off), vv = *(const f32x4*)(p.in[3] + off);
        Kf[j * 65 + c4 * 4 + 0] = kv[0]; Kf[j * 65 + c4 * 4 + 1] = kv[1]; Kf[j * 65 + c4 * 4 + 2] = kv[2]; Kf[j * 65 + c4 * 4 + 3] = kv[3];
        *(LAS f32x4*)(Vf + j * 64 + c4 * 4) = vv;
        if (j >= 1) { const size_t o2 = ((size_t)(b * 128 + j - 1) * 4 + kvh) * 64 + c4 * 4; *(f32x4*)(p.out + O_SK + o2) = kv; *(f32x4*)(p.out + O_SV + o2) = vv; } }
    if (w == 0) { const float kr = bf2f(PA[tok * NA + CK + kvh * 64 + lane]); const float ss = wave_sum(kr * kr);
        const float kn = kr * rsqrtf(ss * (1.0f / 64.0f) + EPS) * p.in[12][lane];
        Kf[128 * 65 + lane] = kn; p.out[O_SK + ((size_t)(b * 128 + 127) * 4 + kvh) * 64 + lane] = kn; }
    else if (w == 1) { const float vr = bf2f(PA[tok * NA + CV + kvh * 64 + lane]); Vf[128 * 64 + lane] = vr; p.out[O_SV + ((size_t)(b * 128 + 127) * 4 + kvh) * 64 + lane] = vr; }
    else if (w < 6) { const int hq = w - 2; const float qr = bf2f(PA[tok * NA + CQ + (kvh * 4 + hq) * 64 + lane]); const float ss = wave_sum(qr * qr);
        qn[hq * 64 + lane] = qr * rsqrtf(ss * (1.0f / 64.0f) + EPS) * p.in[11][lane] * 0.125f; }
    LBAR();
    for (int idx = tid; idx < 4 * 129; idx += 512) { const int hq = idx / 129, j = idx % 129;
        float d = 0.f;
#pragma unroll 8
        for (int e = 0; e < 64; ++e) d += qn[hq * 64 + e] * Kf[j * 65 + e];
        const float slope = exp2f(-0.5f * (float)(kvh * 4 + hq + 1));
        sc[hq * 132 + j] = d - slope * (float)(128 - j); }
    LBAR();
    if (w < 4) { const int hq = w; const float sink = p.in[13][kvh * 4 + hq];
        const float v0 = sc[hq * 132 + lane], v1 = sc[hq * 132 + 64 + lane], v2 = lane == 0 ? sc[hq * 132 + 128] : -INFINITY;
        const float mx = fmaxf(wave_max(fmaxf(fmaxf(v0, v1), v2)), sink);
        const float e0 = __expf(v0 - mx), e1 = __expf(v1 - mx), e2 = lane == 0 ? __expf(v2 - mx) : 0.f;
        const float inv = 1.0f / (wave_sum(e0 + e1 + e2) + __expf(sink - mx));
        sc[hq * 132 + lane] = e0 * inv; sc[hq * 132 + 64 + lane] = e1 * inv; if (lane == 0) sc[hq * 132 + 128] = e2 * inv; }
    LBAR();
    if (tid < 256) { const int hq = w; float o = 0.f;
#pragma unroll 4
        for (int j = 0; j < 129; ++j) o += sc[hq * 132 + j] * Vf[j * 64 + lane];
        AO[tok * 1024 + (kvh * 4 + hq) * 64 + lane] = (bf16)f2bf(o); }
    LBAR();
}

__device__ __forceinline__ void mem_decode_item(const KP& p, LAS unsigned char* lds, int item) {
    const int tid = threadIdx.x, lane = tid & 63, w = tid >> 6;
    const int h = item & 3, b = item >> 2;
    const size_t tok = (size_t)(MP + b);
    LAS float* sc = LDSP(float, 0); LAS float* part = LDSP(float, 1024);
    const bf16* PA = (const bf16*)(p.ws + WS_BIG);
    bf16* MO = (bf16*)(p.ws + WS_MO);
    float q[4];
    {   const v2u qz = *(const v2u*)(PA + tok * NA + CQM + h * 256 + lane * 4);
        q[0] = lo16(qz.x); q[1] = hi16(qz.x); q[2] = lo16(qz.y); q[3] = hi16(qz.y);
        const float ss = wave_sum((q[0] * q[0] + q[1] * q[1]) + (q[2] * q[2] + q[3] * q[3]));
        const float rs = rsqrtf(ss * (1.0f / 256.0f) + EPS) * 0.0625f;
        const f32x4 wq = *(const f32x4*)(p.in[22] + lane * 4);
        q[0] *= rs * wq[0]; q[1] *= rs * wq[1]; q[2] *= rs * wq[2]; q[3] *= rs * wq[3]; }
    const float* Kb = p.in[4] + ((size_t)(b * 256) * 4 + h) * 256;
    const float* Vb = p.in[5] + ((size_t)(b * 256) * 4 + h) * 256;
#pragma unroll 8
    for (int i = 0; i < 32; ++i) { const int m = w * 32 + i;
        const f32x4 kv = *(const f32x4*)(Kb + (size_t)m * 1024 + lane * 4);
        const float d = wave_sum((q[0] * kv[0] + q[1] * kv[1]) + (q[2] * kv[2] + q[3] * kv[3]));
        if (lane == 0) sc[m] = d; }
    LBAR();
    if (w == 0) { const f32x4 v = *(LAS f32x4*)(sc + lane * 4);
        const float mx = wave_max(fmaxf(fmaxf(v[0], v[1]), fmaxf(v[2], v[3])));
        const float e0 = __expf(v[0] - mx), e1 = __expf(v[1] - mx), e2 = __expf(v[2] - mx), e3 = __expf(v[3] - mx);
        const float inv = 1.0f / wave_sum((e0 + e1) + (e2 + e3));
        *(LAS f32x4*)(sc + lane * 4) = (f32x4){e0 * inv, e1 * inv, e2 * inv, e3 * inv}; }
    LBAR();
    {   f32x4 o = {0.f, 0.f, 0.f, 0.f};
#pragma unroll 8
        for (int i = 0; i < 32; ++i) { const int m = w * 32 + i; o += *(const f32x4*)(Vb + (size_t)m * 1024 + lane * 4) * sc[m]; }
        *(LAS f32x4*)(part + w * 256 + lane * 4) = o; }
    LBAR();
    if (tid < 256) { float o = part[tid];
#pragma unroll
        for (int g8 = 1; g8 < 8; ++g8) o += part[g8 * 256 + tid];
        MO[tok * 1024 + h * 256 + tid] = (bf16)f2bf(o); }
    LBAR();
}

__device__ __forceinline__ void ssd_norm_pass(const KP& p) {
    const int tid = threadIdx.x, lane = tid & 63, wave = tid >> 6;
    const int gw = blockIdx.x * 8 + wave, NGW = gridDim.x * 8;
    const float* SSQ = (const float*)(p.ws + WS_SSQ);
    bf16* SO = (bf16*)((unsigned char*)(p.out + O_YP) + YP_SO);
    for (int r = gw; r < MTOK; r += NGW) {
#pragma unroll
        for (int it = 0; it < 4; ++it) {
            const f32x4 a = *(const f32x4*)(SSQ + (size_t)r * 32 + it * 8), c = *(const f32x4*)(SSQ + (size_t)r * 32 + it * 8 + 4);
            const float rs = rsqrtf(((a[0] + a[1]) + (a[2] + a[3]) + (c[0] + c[1]) + (c[2] + c[3])) * (1.0f / 512.0f) + EPS);
            v4u* ptr = (v4u*)(SO + (size_t)r * 2048 + it * 512 + lane * 8);
            const v4u z = *ptr; float t[8]; UNPACK8(z, t);
            v4u o; o.x = pk2(t[0] * rs, t[1] * rs); o.y = pk2(t[2] * rs, t[3] * rs); o.z = pk2(t[4] * rs, t[5] * rs); o.w = pk2(t[6] * rs, t[7] * rs);
            *ptr = o;
        }
    }
    bf16* AO = (bf16*)((unsigned char*)(p.out + O_YP) + YP_AO); bf16* MO = (bf16*)(p.ws + WS_MO);
    const v4u zero = {0u, 0u, 0u, 0u};
    for (int i = blockIdx.x * 512 + tid; i < (MPAD - MTOK) * 256; i += gridDim.x * 512) *((v4u*)(SO + (size_t)MTOK * 2048) + i) = zero;
    for (int i = blockIdx.x * 512 + tid; i < (MPAD - MTOK) * 128; i += gridDim.x * 512) { *((v4u*)(AO + (size_t)MTOK * 1024) + i) = zero; *((v4u*)(MO + (size_t)MTOK * 1024) + i) = zero; }
}


#ifndef NO_SSDP
#define ITEM_SSDP { int b_, h_; if (G_ == 256) { const int xcd = bid & 7, slot = bid >> 3, gi = (slot >> 3) * 8 + xcd; b_ = (it >> 8) * 8 + (gi >> 2); h_ = (gi & 3) * 8 + (slot & 7); } else { b_ = it >> 5; h_ = it & 31; } ssd_prompt_item(p, lds, b_, h_); }
#else
#define ITEM_SSDP
#endif
#ifndef NO_MEMP
#define ITEM_MEMP mem_prompt_item(p, lds, it);
#else
#define ITEM_MEMP
#endif
#ifndef NO_SWAP
#define ITEM_SWAP swa_prompt_item(p, lds, it);
#else
#define ITEM_SWAP
#endif
#ifndef NO_SSDD
#define ITEM_SSDD ssd_decode_item(p, lds, it);
#else
#define ITEM_SSDD
#endif
#ifndef NO_MEMD
#define ITEM_MEMD mem_decode_item(p, lds, it);
#else
#define ITEM_MEMD
#endif
#ifndef NO_SWAD
#define ITEM_SWAD swa_decode_item(p, lds, it);
#else
#define ITEM_SWAD
#endif

#ifndef REP_P0
#define REP_P0 1
#endif
#ifndef REP_P2
#define REP_P2 1
#endif
#ifndef REP_SSDP
#define REP_SSDP REP_P2
#endif
#ifndef REP_MEMP
#define REP_MEMP REP_P2
#endif
#ifndef REP_SWAP
#define REP_SWAP REP_P2
#endif
#ifndef REP_SSDD
#define REP_SSDD REP_P2
#endif
#ifndef REP_MEMD
#define REP_MEMD REP_P2
#endif
#ifndef REP_SWAD
#define REP_SWAD REP_P2
#endif
#ifndef REP_P6
#define REP_P6 1
#endif
#define XB_TMO      128
#define XB_XCNT(j)  (256  + 64 * (j))
#define XB_XSUB(j)  (1280 + 64 * (j))
#define XB_XGEN(j)  (2304 + 64 * (j))
#define XB_TOP      3328
#define XB_TOPGEN   3392
#define XCD_BAR_WORDS 3456
#define XB_SPIN_CAP (1u << 18)

__device__ __forceinline__ unsigned xb_ld(unsigned* p)              { return __hip_atomic_load(p, __ATOMIC_RELAXED, __HIP_MEMORY_SCOPE_AGENT); }
__device__ __forceinline__ unsigned xb_add(unsigned* p, unsigned v) { return __hip_atomic_fetch_add(p, v, __ATOMIC_RELAXED, __HIP_MEMORY_SCOPE_AGENT); }
__device__ __forceinline__ unsigned xb_xcc_id() { return (unsigned)__builtin_amdgcn_s_getreg((3 << 11) | 20) & 0xFu; }
#define XB_SPIN(cond, bar) do { unsigned _sp = 0; while (cond) { __builtin_amdgcn_s_sleep(1); \
    if ((++_sp & 255u) == 0u) { if (xb_ld(&(bar)[XB_TMO])) break; if (_sp > XB_SPIN_CAP) { atomicAdd(&(bar)[XB_TMO], 1u); break; } } } } while (0)

struct XcdBarrier {
    unsigned* bar; unsigned x;
    volatile LAS unsigned* st;
};

__device__ __forceinline__ XcdBarrier xcd_barrier_post(unsigned* bar, volatile LAS unsigned* st) {
    XcdBarrier b; b.bar = bar; b.x = xb_xcc_id(); b.st = st;
    if (threadIdx.x == 0) (void)xb_add(&bar[XB_XCNT(b.x)], 1u);
    return b;
}
__device__ __forceinline__ void xcd_barrier_complete(unsigned* bar, unsigned x, unsigned& nloc, unsigned& nx) {
    const unsigned G = gridDim.x * gridDim.y * gridDim.z;
    unsigned sum, cnt, mine, sp = 0u;
    for (;;) {
        sum = 0u; cnt = 0u; mine = 0u;
#pragma unroll
        for (unsigned j = 0; j < 16; ++j) { const unsigned c = xb_ld(&bar[XB_XCNT(j)]); sum += c; cnt += (c > 0u) ? 1u : 0u; mine = (j == x) ? c : mine; }
        if (sum == G) break;
        __builtin_amdgcn_s_sleep(1);
        if ((++sp & 255u) == 0u) { if (xb_ld(&bar[XB_TMO])) break; if (sp > XB_SPIN_CAP) { atomicAdd(&bar[XB_TMO], 1u); break; } }
    }
    nloc = mine > 0u ? mine : 1u; nx = cnt > 0u ? cnt : 1u;
}

__device__ __forceinline__ void xcd_barrier(const XcdBarrier& b) {
    asm volatile("s_waitcnt vmcnt(0)" ::: "memory");
    __syncthreads();
    if (threadIdx.x == 0) {
        unsigned* bar = b.bar;
        __builtin_amdgcn_s_waitcnt(0);
        unsigned nloc = b.st[0], nx = b.st[1];
        if (nloc == 0u) { xcd_barrier_complete(bar, b.x, nloc, nx); b.st[0] = nloc; b.st[1] = nx; }
        const unsigned old = xb_add(&bar[XB_XSUB(b.x)], 1u);
        const unsigned gen = old / nloc;
        if (old + 1u == (gen + 1u) * nloc) {
            __builtin_amdgcn_fence(__ATOMIC_RELEASE, "agent");
            asm volatile("s_waitcnt vmcnt(0)" ::: "memory");
            const unsigned og = xb_add(&bar[XB_TOP], 1u);
            const unsigned tg = og / nx;
            if (og + 1u == (tg + 1u) * nx) xb_add(&bar[XB_TOPGEN], 1u);
            else XB_SPIN(xb_ld(&bar[XB_TOPGEN]) == tg, bar);
            __builtin_amdgcn_fence(__ATOMIC_ACQUIRE, "agent");
            xb_add(&bar[XB_XGEN(b.x)], 1u);
            asm volatile("s_waitcnt vmcnt(0)" ::: "memory");
        } else {
            XB_SPIN(xb_ld(&bar[XB_XGEN(b.x)]) == gen, bar);
            __builtin_amdgcn_fence(__ATOMIC_ACQUIRE, "agent");
            asm volatile("s_waitcnt vmcnt(0)" ::: "memory");
        }
    }
    __syncthreads();
}


#ifndef STAGGER
#define STAGGER 0
#endif
__device__ __forceinline__ void stagger(int us) {
    if (STAGGER && (blockIdx.x & 7) >= 4) { const unsigned long long t0 = __builtin_amdgcn_s_memrealtime(); while (__builtin_amdgcn_s_memrealtime() - t0 < (unsigned long long)us * 100ull) __builtin_amdgcn_s_sleep(16); }
    __syncthreads();
}
#define GEMM(EpiT, Eobj, Aptr, Bptr, M_, N_, K_, cid) do { pg8::Gemm g_{(const pg8::bf16_t*)(Aptr), (const pg8::bf16_t*)(Bptr), M_, N_, K_}; pg8::StaticOrder S_; S_.init(M_, N_, (int)gridDim.x, (cid)); \
    pg8::gemm_phase<EpiT, pg8::StaticOrder, PG8_ALIGN, PG8_SP2>(lds, g_, S_, Eobj); } while (0)


#ifdef PROBE_TA
#define STAMP(k) do { if (blockIdx.x == 0 && threadIdx.x == 0) ((unsigned long long*)(ws + WS_TS))[k] = __builtin_amdgcn_s_memrealtime(); } while (0)
#else
#define STAMP(k) do { } while (0)
#endif
__global__ void __launch_bounds__(512, 2) mega(KP p) {
    extern __shared__ __attribute__((aligned(16))) unsigned char lds_raw[];
    LAS unsigned char* lds = (LAS unsigned char*)lds_raw;
    cg::grid_group grid = cg::this_grid();
    unsigned char* ws = p.ws;
    const int lo = p.ph_lo, hi = p.ph_hi;
#define IN(k) (lo <= (k) && (k) < hi)
#define SEAM(k) do { if (IN(k) && IN((k) + 1)) xcd_barrier(xb); } while (0)
    bf16* XB = (bf16*)(ws + WS_XB); bf16* MG = (bf16*)(ws + WS_XCX);
    bf16* PA = (bf16*)(ws + WS_BIG); bf16* GATES = PA; bf16* GATES_S = (bf16*)(ws + WS_BIG + (size_t)MP * NG * 2); bf16* ACT = (bf16*)(ws + WS_BIG + BIG_ACT); bf16* X1B = (bf16*)(ws + WS_BIG + BIG_X1B);
    bf16* AO = (bf16*)((unsigned char*)(p.out + O_YP) + YP_AO); bf16* SO = (bf16*)((unsigned char*)(p.out + O_YP) + YP_SO); bf16* MO = (bf16*)(ws + WS_MO);
    float* RS1 = (float*)(ws + WS_RS1); float* RSM = (float*)(ws + WS_RSM); float* PART = (float*)(ws + WS_PART);
    const int bid = (int)blockIdx.x;
    STAMP(0);
    volatile LAS unsigned* xst = (volatile LAS unsigned*)(lds + LDS_BYTES - 16);
    if (threadIdx.x < 2) xst[threadIdx.x] = 0u;
    if (bid == 0) for (int i = threadIdx.x; i < XCD_BAR_WORDS; i += 512) ((unsigned*)(ws + WS_BAR))[i] = 0u;
    __syncthreads();

    if (IN(0))
_Pragma("nounroll")
    for (int rep_ = 0; rep_ < REP_P0; ++rep_) { prologue(p, lds); __syncthreads(); }
    if (IN(0) && IN(1)) grid.sync();
    XcdBarrier xb = xcd_barrier_post((unsigned*)(ws + WS_BAR), xst);
    STAMP(1);
    if (IN(1)) {
        stagger(24);
        EpiProj<0> E1{PA, NA, RS1, (float*)(ws + WS_DT), CDT, 32, 32, 0};
        GEMM(EpiProj<0>, E1, XB, ws + WS_WIN, MP, NA, 2048, bid);
        EpiProj<0> E2{(bf16*)(ws + WS_MKV), 2048, RSM, p.out + O_PMV, 1024, 1024, 1024, 0};
        GEMM(EpiProj<0>, E2, ws + WS_MB, ws + WS_WM, 4096, 2048, 2048, (int)gridDim.x - 1 - bid);
        skinny_proj<0>(lds, XB + (size_t)MP * 2048, (const bf16*)(ws + WS_WIN), NA, 2048, PA, NA, RS1, (float*)(ws + WS_DT), CDT, 32, 32);
    }
    SEAM(1); STAMP(2);
    if (IN(2)) {
        const int G_ = (int)gridDim.x;
        conv_prepass(p);
        memk_norm_pass(p);
        for (int rep_ = 0; rep_ < REP_SWAP; ++rep_) swa_prompt_all(p, lds, bid, G_, 1024);
        for (int it_ = bid; it_ < 4096 * REP_SSDD; it_ += G_) { const int it = it_ & 4095; ITEM_SSDD }
        for (int it_ = bid; it_ < 512 * REP_MEMD; it_ += G_) { const int it = it_ & 511; ITEM_MEMD }
        for (int it_ = bid; it_ < 512 * REP_SWAD; it_ += G_) { const int it = it_ & 511; ITEM_SWAD }
        xcd_barrier(xb);
        STAMP(3);
        for (int it_ = bid; it_ < 512 * REP_SSDP; it_ += G_) { const int it = it_ & 511; ITEM_SSDP }
        for (int it_ = bid; it_ < 1024 * REP_MEMP; it_ += G_) { const int it = it_ & 1023; ITEM_MEMP }
    }
    SEAM(2); STAMP(4);
    if (IN(3)) {
        ssd_norm_pass(p);
        late_weights(p, lds);
        stagger(24);
        EpiProj<1> E{GATES, NG, RS1, nullptr, 0, 0, 0, 128};
        GEMM(EpiProj<1>, E, XB, ws + WS_WIN + (size_t)NA * 2048 * 2, MP, NG, 2048, bid);
        skinny_proj<1>(lds, XB + (size_t)MP * 2048, (const bf16*)(ws + WS_WIN + (size_t)NA * 2048 * 2), NG, 2048, GATES_S - (size_t)MP * NG, NG, RS1, nullptr, 0, 0, 0);
    }
    SEAM(3); STAMP(5);
    if (IN(4)) {
        stagger(15);
        EpiMerge<0> Ea{MG, GATES};
        GEMM(EpiMerge<0>, Ea, AO, ws + WS_WSWA, MP, 2048, 1024, bid);
        EpiMerge<1> Eb{MG, GATES + ((size_t)(16 * 128) << 16)};
        GEMM(EpiMerge<1>, Eb, MO, ws + WS_WMEM, MP, 2048, 1024, bid);
        EpiMerge<1> Ec{MG, GATES + ((size_t)(8 * 128) << 16)};
        GEMM(EpiMerge<1>, Ec, SO, ws + WS_WSSD, MP, 2048, 2048, bid);
        skinny_merge<0>(lds, AO + (size_t)MP * 1024, (const bf16*)(ws + WS_WSWA), 1024, MG, GATES_S - (size_t)MP * NG);
        skinny_merge<1>(lds, MO + (size_t)MP * 1024, (const bf16*)(ws + WS_WMEM), 1024, MG, GATES_S - (size_t)MP * NG + 4096);
        skinny_merge<1>(lds, SO + (size_t)MP * 2048, (const bf16*)(ws + WS_WSSD), 2048, MG, GATES_S - (size_t)MP * NG + 2048);
    }
    SEAM(4); STAMP(6);
    if (IN(5)) {
        stagger(28);
        EpiWout E{XB, X1B, PART};
        GEMM(EpiWout, E, MG, ws + WS_WOUT, MP, 2048, 2048, bid);
        skinny_wout(lds, MG + (size_t)MP * 2048, (const bf16*)(ws + WS_WOUT), p.in[1], X1B, (float*)(ws + WS_PARTS));
    }
    SEAM(5); STAMP(7);
    if (IN(6))
_Pragma("nounroll")
    for (int rep_ = 0; rep_ < REP_P6; ++rep_) {
        stagger(28);
        EpiFfnUp E{PART, ACT};
        GEMM(EpiFfnUp, E, X1B, ws + WS_WGU, MP, 2 * DFF, 2048, bid);
        skinny_ffn_up(lds, X1B + (size_t)MP * 2048, (const bf16*)(ws + WS_WGU), (const float*)(ws + WS_PARTS), ACT);
    }
    SEAM(6); STAMP(8);
    if (IN(7)) {
        EpiDown E{p.out + O_YP, p.out + O_YS, X1B};
        GEMM(EpiDown, E, ACT, ws + WS_WD, MP, 2048, DFF, bid);
        skinny_down(lds, ACT + (size_t)MP * DFF, (const bf16*)(ws + WS_WD), p.out + O_YS, X1B);
    }
#ifdef PROBE_TA
    if (blockIdx.x == 0) { __syncthreads(); if (threadIdx.x == 0) {
        unsigned long long* TS = (unsigned long long*)(ws + WS_TS); TS[9] = __builtin_amdgcn_s_memrealtime();
#ifdef PROBE_TB
        const unsigned long long ta = TS[PROBE_TA + 1] - TS[PROBE_TA], tb = TS[PROBE_TB + 1] - TS[PROBE_TB];
        unsigned long long qa = (ta + 1000) / 2000, qb = (tb + 1000) / 2000; if (qa > 99) qa = 99; if (qb > 99) qb = 99;
        const unsigned long long wait = 2000ull * (qa + 100ull * qb), t0 = __builtin_amdgcn_s_memrealtime();
#else
        const unsigned long long wait = TS[PROBE_TA + 1] - TS[PROBE_TA], t0 = __builtin_amdgcn_s_memrealtime();
#endif
        while (__builtin_amdgcn_s_memrealtime() - t0 < wait) __builtin_amdgcn_s_sleep(32);
    } }
#endif
#undef IN
#undef SEAM
}

#ifndef N_LAUNCHES
#define N_LAUNCHES 1
#endif
extern "C" void kernel_launch(void* const* d_in, const int* in_sizes, int n_in, void* d_out, int out_size, void* d_ws, size_t ws_size, hipStream_t stream) {
    static int grid = 0;
    if (grid == 0) {
        if (n_in != 32 || (size_t)out_size != O_END || ws_size < WS_END) { fprintf(stderr, "kernel_launch: unexpected sizes n_in %d out %d ws %zu (need %zu)\n", n_in, out_size, ws_size, (size_t)WS_END); grid = -1; return; }
        int dev = 0, cus = 0, per_cu = 0;
        hipGetDevice(&dev); hipDeviceGetAttribute(&cus, hipDeviceAttributeMultiprocessorCount, dev);
        if (hipFuncSetAttribute((const void*)mega, hipFuncAttributeMaxDynamicSharedMemorySize, LDS_BYTES) != hipSuccess) { fprintf(stderr, "kernel_launch: hipFuncSetAttribute failed\n"); grid = -1; return; }
        if (hipOccupancyMaxActiveBlocksPerMultiprocessor(&per_cu, (const void*)mega, 512, LDS_BYTES) != hipSuccess || per_cu < 1) { fprintf(stderr, "kernel_launch: occupancy query says %d\n", per_cu); per_cu = 1; }
        (void)hipGetLastError();
        grid = cus;
    }
    if (grid < 0) return;
    KP p{};
    for (int i = 0; i < 32; ++i) p.in[i] = (const float*)d_in[i];
    p.out = (float*)d_out; p.ws = (unsigned char*)d_ws;
#if N_LAUNCHES == 1
    p.ph_lo = 0; p.ph_hi = 8;
    void* args[] = {&p};
    hipError_t e = hipLaunchCooperativeKernel((const void*)mega, dim3(grid), dim3(512), args, LDS_BYTES, stream);
    if (e != hipSuccess) fprintf(stderr, "cooperative launch failed: %s (grid %d)\n", hipGetErrorString(e), grid);
#else
    for (int k = 0; k < 8; ++k) { p.ph_lo = k; p.ph_hi = k + 1; hipLaunchKernelGGL(mega, dim3(grid), dim3(512), LDS_BYTES, stream, p); }
#endif
}
```

```cpp
#include <hip/hip_runtime.h>
#include <hip/hip_cooperative_groups.h>
#include <cstdio>
#include <cstdint>
namespace cg = cooperative_groups;
namespace pg8 {
#define PG8_LAS __attribute__((address_space(3)))
typedef unsigned short bf16_t;
typedef short bf16x8 __attribute__((ext_vector_type(8)));
typedef float f32x4 __attribute__((ext_vector_type(4)));
typedef unsigned u32x4 __attribute__((ext_vector_type(4)));
constexpr int BM = 256, BK = 64, HALF = 128, HTB = HALF * BK * 2  , STAGE_BYTES = 8 * HTB, NXCD = 8, WGM = 4;

__host__ __device__ __forceinline__ int lds_byte(int r, int c) { const int st = (r >> 4) * 2 + (c >> 5), rr = r & 15, cc = c & 31, ob = rr * 64 + cc * 2; return st * 1024 + (ob ^ (((ob >> 9) & 1) << 5)); }
__host__ __device__ __forceinline__ void stage_rc(int b, int& R, int& C) { const int st = b / 1024, sb = b % 1024, swz = sb ^ (((sb >> 9) & 1) << 5); R = (st >> 1) * 16 + swz / 64; C = (st & 1) * 32 + (swz % 64) / 2; }
__host__ __device__ __forceinline__ int perm32(int rho) { const int n = rho >> 4, i = rho & 15; return 8 * (i >> 2) + 4 * n + (i & 3); }

struct Unit { int pm, pn; };
struct Gemm { const bf16_t* A; const bf16_t* Bt; int M, N, K; };
struct StaticOrder {
    int nM, nN, nwg, G, c;
    __host__ __device__ void init(int M, int N, int G_, int c_) { nM = M / BM; nN = N / BM; nwg = nM * nN; G = G_; c = c_; }
    __host__ __device__ bool next(int i, Unit& u) const {
        const long L = (long)i * G + c; if (L >= nwg) return false;
        int wgid = (int)L; { const int q = nwg / NXCD, r = nwg % NXCD, xcd = wgid % NXCD, off = wgid / NXCD; wgid = (xcd < r ? xcd * (q + 1) : r * (q + 1) + (xcd - r) * q) + off; }
        const int nig = WGM * nN, gid = wgid / nig, fm = gid * WGM, gsz = (nM - fm) < WGM ? (nM - fm) : WGM;
        u.pm = fm + ((wgid % nig) % gsz); u.pn = (wgid % nig) / gsz; return true;
    }
    __device__ __forceinline__ void a_ready(const Unit&) const {}
    __device__ __forceinline__ void done(const Unit&) const {}
};

__device__ __forceinline__ unsigned cvt_pk_bf16(float lo, float hi) { unsigned r; asm volatile("v_cvt_pk_bf16_f32 %0, %1, %2" : "=v"(r) : "v"(lo), "v"(hi)); return r; }
typedef float f32x2 __attribute__((ext_vector_type(2)));
template <class Epi, class Sched, bool ALIGN_EPI = false, bool SP2 = false>
__device__ __forceinline__ void gemm_phase(PG8_LAS unsigned char* lds, const Gemm g, const Sched& S, const Epi& E) {
    const int tid = threadIdx.x, wid = __builtin_amdgcn_readfirstlane(tid >> 6), lane = tid & 63, wr = wid >> 2, wc = wid & 3, fr = lane & 15, fq = lane >> 4;
    const int K = g.K, nt = K / BK;
    unsigned voffA[2], voffB[2];
#pragma unroll
    for (int i = 0; i < 2; ++i) { int R, C; stage_rc(tid * 16 + i * 8192, R, C); const int Rb = Epi::PERM ? ((R & ~31) + perm32(R & 31)) : R;
        voffA[i] = (unsigned)(R * K + C) * 2u; voffB[i] = (unsigned)(Rb * K + C) * 2u; }
    const size_t kstep = (size_t)(BK * 2);
    const size_t hstep = (size_t)HALF * K * 2;
    const size_t tstep = 2 * hstep;
    const unsigned ldsw = (unsigned)wid * 1024u;
    const int aoff = lds_byte(wr * 64 + fr, fq * 8), boff = lds_byte(wc * 32 + fr, fq * 8);
#define PG8_SA(b, h) (((b) * 2 + (h)) * HTB)
#define PG8_SB(b, h) ((4 + (b) * 2 + (h)) * HTB)
#define PG8_STAGE(bufoff, gbase, voff) do { _Pragma("unroll") for (int _i = 0; _i < 2; ++_i) \
        __builtin_amdgcn_global_load_lds((const unsigned*)((const char*)(gbase) + (voff)[_i]), (PG8_LAS unsigned*)(lds + (bufoff) + ldsw + _i * 8192), 16, 0, 0); } while (0)
#define PG8_LDA(dst, b, h) do { _Pragma("unroll") for (int m = 0; m < 4; ++m) _Pragma("unroll") for (int k = 0; k < 2; ++k) dst[m][k] = *(const PG8_LAS bf16x8*)(lds + PG8_SA(b, h) + aoff + m * 2048 + k * 1024); } while (0)
#define PG8_LDB(dst, b, h) do { _Pragma("unroll") for (int n = 0; n < 2; ++n) _Pragma("unroll") for (int k = 0; k < 2; ++k) dst[n][k] = *(const PG8_LAS bf16x8*)(lds + PG8_SB(b, h) + boff + n * 2048 + k * 1024); } while (0)
#define PG8_MMA(ai, bj, At, Bt) do { __builtin_amdgcn_s_setprio(1); _Pragma("unroll") for (int m = 0; m < 4; ++m) _Pragma("unroll") for (int n = 0; n < 2; ++n) _Pragma("unroll") for (int k = 0; k < 2; ++k) \
        acc[ai][bj][m][n] = __builtin_amdgcn_mfma_f32_16x16x32_bf16(Bt[n][k], At[m][k], acc[ai][bj][m][n], 0, 0, 0); __builtin_amdgcn_s_setprio(0); } while (0)
#define PG8_WAIT_V(n) asm volatile("s_waitcnt vmcnt(" #n ")" ::: "memory")
#define PG8_WAIT_L(n) asm volatile("s_waitcnt lgkmcnt(" #n ")" ::: "memory")
#define PG8_BAR __builtin_amdgcn_s_barrier()
#define PG8_SCHED __builtin_amdgcn_sched_barrier(0)
    Unit cur, nxt; int ui = 0;
    if (!S.next(0, cur)) return;
    f32x4 acc[2][2][4][2];
#pragma unroll
    for (int a = 0; a < 2; ++a)
#pragma unroll
        for (int b = 0; b < 2; ++b)
#pragma unroll
            for (int m = 0; m < 4; ++m)
#pragma unroll
                for (int n = 0; n < 2; ++n) acc[a][b][m][n] = (f32x4){0.f, 0.f, 0.f, 0.f};
    bf16x8 At[4][2], B0[2][2], B1[2][2];
    const char* cA = (const char*)g.A + (size_t)cur.pm * tstep; const char* cB = (const char*)g.Bt + (size_t)cur.pn * tstep;
    S.a_ready(cur);
    if constexpr (SP2) {
        PG8_STAGE(PG8_SB(0, 0), cB, voffB); PG8_STAGE(PG8_SB(0, 1), cB + hstep, voffB); PG8_STAGE(PG8_SA(0, 0), cA, voffA); PG8_STAGE(PG8_SA(0, 1), cA + hstep, voffA);
        if (wr == 1) PG8_BAR;
        PG8_WAIT_V(2); PG8_BAR;
        PG8_STAGE(PG8_SB(1, 0), cB + kstep, voffB); PG8_STAGE(PG8_SA(1, 0), cA + kstep, voffA); PG8_STAGE(PG8_SB(1, 1), cB + hstep + kstep, voffB);
        PG8_WAIT_V(6); PG8_BAR;
    } else {
        PG8_STAGE(PG8_SB(0, 0), cB, voffB); PG8_STAGE(PG8_SA(0, 0), cA, voffA); PG8_STAGE(PG8_SB(0, 1), cB + hstep, voffB); PG8_STAGE(PG8_SA(0, 1), cA + hstep, voffA);
        if (wr == 1) PG8_BAR;
        PG8_WAIT_V(4); PG8_BAR;
        PG8_STAGE(PG8_SB(1, 0), cB + kstep, voffB); PG8_STAGE(PG8_SA(1, 0), cA + kstep, voffA); PG8_STAGE(PG8_SB(1, 1), cB + hstep + kstep, voffB);
        PG8_WAIT_V(6); PG8_BAR;
    }
    for (;;) {
        const bool has_next = S.next(ui + 1, nxt);
        const char* nA = has_next ? (const char*)g.A + (size_t)nxt.pm * tstep : cA; const char* nB = has_next ? (const char*)g.Bt + (size_t)nxt.pn * tstep : cB;
        for (int t = 0; t < nt; t += 2) {
            const bool last = (t == nt - 2);
            const char* a1 = cA + (size_t)(t + 1) * kstep;
            const char* a2 = last ? nA : cA + (size_t)(t + 2) * kstep; const char* b2 = last ? nB : cB + (size_t)(t + 2) * kstep;
            const char* a3 = a2 + kstep; const char* b3 = b2 + kstep;
            if (last && has_next) S.a_ready(nxt);
            if constexpr (SP2) {
            PG8_LDB(B0, 0, 0); PG8_LDB(B1, 0, 1); PG8_SCHED; PG8_LDA(At, 0, 0); PG8_STAGE(PG8_SA(1, 1), a1 + hstep, voffA);
            PG8_WAIT_V(8); PG8_WAIT_L(0); PG8_BAR; PG8_MMA(0, 0, At, B0); PG8_MMA(0, 1, At, B1); PG8_BAR; PG8_SCHED;
            PG8_LDA(At, 0, 1); PG8_STAGE(PG8_SB(0, 0), b2, voffB); PG8_STAGE(PG8_SB(0, 1), b2 + hstep, voffB); PG8_STAGE(PG8_SA(0, 0), a2, voffA);
            PG8_WAIT_V(8); PG8_WAIT_L(0); PG8_BAR; PG8_MMA(1, 0, At, B0); PG8_MMA(1, 1, At, B1); PG8_BAR; PG8_SCHED;
            PG8_LDB(B0, 1, 0); PG8_LDB(B1, 1, 1); PG8_SCHED; PG8_LDA(At, 1, 0); PG8_STAGE(PG8_SA(0, 1), a2 + hstep, voffA);
            PG8_WAIT_V(8); PG8_WAIT_L(0); PG8_BAR; PG8_MMA(0, 0, At, B0); PG8_MMA(0, 1, At, B1); PG8_BAR; PG8_SCHED;
            PG8_LDA(At, 1, 1); PG8_STAGE(PG8_SB(1, 0), b3, voffB); PG8_STAGE(PG8_SB(1, 1), b3 + hstep, voffB); PG8_STAGE(PG8_SA(1, 0), a3, voffA);
            PG8_WAIT_V(8); PG8_WAIT_L(0); PG8_BAR; PG8_MMA(1, 0, At, B0); PG8_MMA(1, 1, At, B1); PG8_BAR; PG8_SCHED;
            } else {
            PG8_LDB(B0, 0, 0); PG8_SCHED; PG8_LDA(At, 0, 0); PG8_STAGE(PG8_SA(1, 1), a1 + hstep, voffA);
            PG8_WAIT_L(8); PG8_BAR; PG8_WAIT_L(0); PG8_MMA(0, 0, At, B0); PG8_BAR; PG8_SCHED;
            PG8_LDB(B1, 0, 1); PG8_STAGE(PG8_SB(0, 0), b2, voffB);
            PG8_BAR; PG8_WAIT_L(0); PG8_MMA(0, 1, At, B1); PG8_BAR;
            PG8_LDA(At, 0, 1); PG8_STAGE(PG8_SA(0, 0), a2, voffA);
            PG8_BAR; PG8_WAIT_L(0); PG8_MMA(1, 0, At, B0); PG8_BAR; PG8_SCHED;
            PG8_STAGE(PG8_SB(0, 1), b2 + hstep, voffB);
            PG8_WAIT_V(6); PG8_BAR; PG8_MMA(1, 1, At, B1); PG8_BAR;
            PG8_LDB(B0, 1, 0); PG8_SCHED; PG8_LDA(At, 1, 0); PG8_STAGE(PG8_SA(0, 1), a2 + hstep, voffA);
            PG8_WAIT_L(8); PG8_BAR; PG8_WAIT_L(0); PG8_MMA(0, 0, At, B0); PG8_BAR; PG8_SCHED;
            PG8_LDB(B1, 1, 1); PG8_STAGE(PG8_SB(1, 0), b3, voffB);
            PG8_BAR; PG8_WAIT_L(0); PG8_MMA(0, 1, At, B1); PG8_BAR;
            PG8_LDA(At, 1, 1); PG8_STAGE(PG8_SA(1, 0), a3, voffA);
            PG8_BAR; PG8_WAIT_L(0); PG8_MMA(1, 0, At, B0); PG8_BAR; PG8_SCHED;
            PG8_STAGE(PG8_SB(1, 1), b3 + hstep, voffB);
            PG8_WAIT_V(6); PG8_BAR; PG8_MMA(1, 1, At, B1); PG8_BAR;
            }
        }
        if constexpr (ALIGN_EPI) { if (wr == 0) PG8_BAR; }
        if constexpr (!Epi::AFTER_DRAIN) { E(acc, cur, wr, wc, fr, fq); S.done(cur); }
        if (!has_next) break;
#pragma unroll
        for (int a = 0; a < 2; ++a)
#pragma unroll
            for (int b = 0; b < 2; ++b)
#pragma unroll
                for (int m = 0; m < 4; ++m)
#pragma unroll
                    for (int n = 0; n < 2; ++n) acc[a][b][m][n] = (f32x4){0.f, 0.f, 0.f, 0.f};
        cur = nxt; cA = nA; cB = nB; ++ui;
        if constexpr (ALIGN_EPI) { if (wr == 1) PG8_BAR; }
    }
    PG8_WAIT_V(0);
    if constexpr (!ALIGN_EPI) { if (wr == 0) PG8_BAR; }
    PG8_BAR;
    if constexpr (Epi::AFTER_DRAIN) { E.fused(acc, cur, wr, wc, fr, fq, lds, wid, lane); S.done(cur); }
#undef PG8_SA
#undef PG8_SB
#undef PG8_STAGE
#undef PG8_LDA
#undef PG8_LDB
#undef PG8_MMA
#undef PG8_WAIT_V
#undef PG8_WAIT_L
#undef PG8_BAR
#undef PG8_SCHED
}
}

#ifndef PG8_SP2
#define PG8_SP2 true
#endif
#ifndef PG8_ALIGN
#define PG8_ALIGN true
#endif

#define LAS __attribute__((address_space(3)))
typedef unsigned short bf16;
typedef short bf16x8 __attribute__((ext_vector_type(8)));
typedef float f32x4 __attribute__((ext_vector_type(4)));
typedef unsigned v4u __attribute__((ext_vector_type(4)));
typedef unsigned v2u __attribute__((ext_vector_type(2)));

constexpr int DM = 2048, SEQ = 2048, NBATCH = 16, MP = NBATCH * SEQ, MS = 128, MTOK = MP + MS, MPAD = 33024;
constexpr int NA = 7936, NG = 6144, NIN = 14080, DFF = 5632, CONVCH = 3072;
constexpr int CQ = 0, CK = 1024, CV = 1280, CZ = 1536, CXBC = 3584, CDT = 6656, CQM = 6912;
constexpr float EPS = 1e-6f;
constexpr int LDS_BYTES = 147456;

constexpr size_t O_YP = 0, O_YS = O_YP + (size_t)MP * DM, O_PK = O_YS + (size_t)MS * DM, O_PV = O_PK + 524288, O_PMK = O_PV + 524288, O_PMV = O_PMK + 4194304,
                 O_PSSM = O_PMV + 4194304, O_PCONV = O_PSSM + 4194304, O_SK = O_PCONV + 147456, O_SV = O_SK + 4194304, O_SSSM = O_SV + 4194304, O_SCONV = O_SSSM + 33554432,
                 O_END = O_SCONV + 1179648;
constexpr size_t WS_WIN = 0, WS_WM = WS_WIN + (size_t)NIN * 2048 * 2, WS_WSWA = WS_WM + 2048u * 2048 * 2, WS_WSSD = WS_WSWA + 2048u * 1024 * 2, WS_WMEM = WS_WSSD + 2048u * 2048 * 2,
                 WS_WOUT = WS_WMEM + 2048u * 1024 * 2, WS_WGU = WS_WOUT + 2048u * 2048 * 2, WS_WD = WS_WGU + (size_t)2 * DFF * 2048 * 2, WS_XB = WS_WD + (size_t)2048 * DFF * 2,
                 WS_MB = WS_XB + (size_t)MPAD * 2048 * 2, WS_MKV = WS_MB + 4096u * 2048 * 2, WS_BIG = WS_MKV + 4096u * 2048 * 2, WS_MO = WS_BIG + (size_t)MPAD * NA * 2,
                 WS_DT = WS_MO + (size_t)MPAD * 1024 * 2, WS_SSQ = WS_DT + (size_t)MPAD * 32 * 4, WS_RS1 = WS_SSQ + (size_t)MPAD * 32 * 4, WS_RSM = WS_RS1 + (size_t)MPAD * 4,
                 WS_PART = WS_RSM + 4096u * 4, WS_TS = WS_PART + (size_t)MPAD * 32 * 4, WS_PARTS = WS_TS + 256, WS_BAR = WS_PARTS + 128 * 64 * 4, WS_XCX = WS_BAR + 16384, WS_END = WS_XCX + (size_t)MPAD * 2048 * 2;
constexpr size_t WS_XCBC = WS_WGU;
static_assert((size_t)MP * 1024 * 2 <= WS_XB - WS_WGU, "XCbc fits");
static_assert(WS_END <= 1073741824u, "workspace budget");
constexpr size_t BIG_ACT = 0, BIG_X1B = (size_t)MPAD * DFF * 2;
static_assert(BIG_X1B + (size_t)MPAD * 2048 * 2 <= (size_t)MPAD * NA * 2, "big overlay");
constexpr size_t YP_AO = 0, YP_SO = (size_t)MPAD * 1024 * 2;
static_assert(YP_SO + (size_t)MPAD * 2048 * 2 <= (size_t)MP * DM * 4, "AO/SO fit in y_prompt");

struct KP { const float* in[32]; float* out; unsigned char* ws; int ph_lo, ph_hi; };

__device__ __forceinline__ float bf2f(unsigned v) { return __uint_as_float(v << 16); }
typedef float f32x2_t __attribute__((ext_vector_type(2))); typedef __bf16 bf16x2_t __attribute__((ext_vector_type(2)));
__device__ __forceinline__ unsigned pk2(float lo, float hi) { const f32x2_t v = {lo, hi}; const bf16x2_t b = __builtin_convertvector(v, bf16x2_t); return __builtin_bit_cast(unsigned, b); }
__device__ __forceinline__ unsigned f2bf(float f) { return pk2(f, f) & 0xffffu; }
__device__ __forceinline__ float lo16(unsigned w) { return __uint_as_float(w << 16); }
__device__ __forceinline__ float hi16(unsigned w) { return __uint_as_float(w & 0xffff0000u); }
__device__ __forceinline__ float sigmoidf_(float x) { return __builtin_amdgcn_rcpf(1.0f + __expf(-x)); }
__device__ __forceinline__ float siluf_(float x) { return x * __builtin_amdgcn_rcpf(1.0f + __expf(-x)); }
__device__ __forceinline__ float wave_sum(float v) {
#pragma unroll
    for (int o = 1; o < 64; o <<= 1) v += __shfl_xor(v, o);
    return v;
}
__device__ __forceinline__ float wave_max(float v) {
#pragma unroll
    for (int o = 1; o < 64; o <<= 1) v = fmaxf(v, __shfl_xor(v, o));
    return v;
}
__device__ __forceinline__ f32x4 mfma16(bf16x8 a, bf16x8 b, f32x4 c) { return __builtin_amdgcn_mfma_f32_16x16x32_bf16(a, b, c, 0, 0, 0); }
#define LBAR() asm volatile("s_waitcnt lgkmcnt(0)\n\ts_barrier" ::: "memory")
#define UNPACK8(W_, F_) do { F_[0] = lo16((W_)[0]); F_[1] = hi16((W_)[0]); F_[2] = lo16((W_)[1]); F_[3] = hi16((W_)[1]); F_[4] = lo16((W_)[2]); F_[5] = hi16((W_)[2]); F_[6] = lo16((W_)[3]); F_[7] = hi16((W_)[3]); } while (0)

template <int ACT> struct EpiProj {
    static constexpr bool PERM = true, AFTER_DRAIN = false;
    bf16* O; int ldc; const float* rs; float* f32o; int fc0, fw, fld; int tiled;
    __device__ __forceinline__ void operator()(const pg8::f32x4 (&acc)[2][2][4][2], const pg8::Unit& u, int wr, int wc, int fr, int fq) const {
#pragma unroll
        for (int ai = 0; ai < 2; ++ai)
#pragma unroll
            for (int m = 0; m < 4; ++m) {
                const int row = u.pm * 256 + ai * 128 + wr * 64 + m * 16 + fr; const float s = rs[row];
#pragma unroll
                for (int bj = 0; bj < 2; ++bj) {
                    const int col = u.pn * 256 + bj * 128 + wc * 32 + 8 * fq;
                    f32x4 v0 = acc[ai][bj][m][0] * s, v1 = acc[ai][bj][m][1] * s;
                    if (ACT == 1) { v0[0] = sigmoidf_(v0[0]); v0[1] = sigmoidf_(v0[1]); v0[2] = sigmoidf_(v0[2]); v0[3] = sigmoidf_(v0[3]);
                                    v1[0] = sigmoidf_(v1[0]); v1[1] = sigmoidf_(v1[1]); v1[2] = sigmoidf_(v1[2]); v1[3] = sigmoidf_(v1[3]); }
                    v4u w; w.x = pk2(v0[0], v0[1]); w.y = pk2(v0[2], v0[3]); w.z = pk2(v1[0], v1[1]); w.w = pk2(v1[2], v1[3]);
                    if (tiled) *(v4u*)(O + (((size_t)(u.pn * tiled + u.pm)) << 16) + (ai * 128 + wr * 64 + m * 16 + fr) * 256 + bj * 128 + wc * 32 + 8 * fq) = w;
                    else *(v4u*)(O + (size_t)row * ldc + col) = w;
                    if (f32o && col >= fc0 && col < fc0 + fw) { float* d = f32o + (size_t)row * fld + (col - fc0); *(f32x4*)d = v0; *(f32x4*)(d + 4) = v1; }
                }
            }
    }
};
template <int ACCUM> struct EpiMerge {
    static constexpr bool PERM = true, AFTER_DRAIN = false;
    bf16* MG; const bf16* G;
    __device__ __forceinline__ void operator()(const pg8::f32x4 (&acc)[2][2][4][2], const pg8::Unit& u, int wr, int wc, int fr, int fq) const {
#pragma unroll
        for (int ai = 0; ai < 2; ++ai)
#pragma unroll
            for (int m = 0; m < 4; ++m) {
                const int row = u.pm * 256 + ai * 128 + wr * 64 + m * 16 + fr;
#pragma unroll
                for (int bj = 0; bj < 2; ++bj) {
                    const int col = u.pn * 256 + bj * 128 + wc * 32 + 8 * fq;
                    const v4u gw = *(const v4u*)(G + (((size_t)(u.pn * 128 + u.pm)) << 16) + (ai * 128 + wr * 64 + m * 16 + fr) * 256 + bj * 128 + wc * 32 + 8 * fq);
                    float g[8]; UNPACK8(gw, g);
                    const f32x4 a0 = acc[ai][bj][m][0], a1 = acc[ai][bj][m][1];
                    float v[8] = {g[0] * a0[0], g[1] * a0[1], g[2] * a0[2], g[3] * a0[3], g[4] * a1[0], g[5] * a1[1], g[6] * a1[2], g[7] * a1[3]};
                    bf16* dst = MG + (size_t)row * 2048 + col;
                    if (ACCUM) { const v4u ow = *(const v4u*)dst; float o[8]; UNPACK8(ow, o);
#pragma unroll
                        for (int e = 0; e < 8; ++e) v[e] += o[e]; }
                    v4u w; w.x = pk2(v[0], v[1]); w.y = pk2(v[2], v[3]); w.z = pk2(v[4], v[5]); w.w = pk2(v[6], v[7]);
                    *(v4u*)dst = w;
                }
            }
    }
};
struct EpiWout {
    static constexpr bool PERM = true, AFTER_DRAIN = false;
    const bf16* XBp; bf16* X1B; float* part;
    __device__ __forceinline__ void operator()(const pg8::f32x4 (&acc)[2][2][4][2], const pg8::Unit& u, int wr, int wc, int fr, int fq) const {
#pragma unroll
        for (int ai = 0; ai < 2; ++ai)
#pragma unroll
            for (int m = 0; m < 4; ++m) {
                const int row = u.pm * 256 + ai * 128 + wr * 64 + m * 16 + fr;
                float ps = 0.f;
#pragma unroll
                for (int bj = 0; bj < 2; ++bj) {
                    const int col = u.pn * 256 + bj * 128 + wc * 32 + 8 * fq;
                    f32x4 v0 = {0.f, 0.f, 0.f, 0.f}, v1 = {0.f, 0.f, 0.f, 0.f};
                    { const v4u xw = *(const v4u*)(XBp + (size_t)row * DM + col); float xf[8]; UNPACK8(xw, xf);
                      v0 = (f32x4){xf[0], xf[1], xf[2], xf[3]} + acc[ai][bj][m][0]; v1 = (f32x4){xf[4], xf[5], xf[6], xf[7]} + acc[ai][bj][m][1]; }
                    v4u w; w.x = pk2(v0[0], v0[1]); w.y = pk2(v0[2], v0[3]); w.z = pk2(v1[0], v1[1]); w.w = pk2(v1[2], v1[3]);
                    *(v4u*)(X1B + (size_t)row * DM + col) = w;
                    ps += (v0[0] * v0[0] + v0[1] * v0[1]) + (v0[2] * v0[2] + v0[3] * v0[3]) + (v1[0] * v1[0] + v1[1] * v1[1]) + (v1[2] * v1[2] + v1[3] * v1[3]);
                }
                ps += __shfl_xor(ps, 16); ps += __shfl_xor(ps, 32);
                if (fq == 0) part[(size_t)row * 32 + u.pn * 4 + wc] = ps;
            }
    }
};
struct EpiFfnUp {
    static constexpr bool PERM = true, AFTER_DRAIN = false;
    const float* part; bf16* ACT;
    __device__ __forceinline__ void operator()(const pg8::f32x4 (&acc)[2][2][4][2], const pg8::Unit& u, int wr, int wc, int fr, int fq) const {
#pragma unroll
        for (int ai = 0; ai < 2; ++ai)
#pragma unroll
            for (int m = 0; m < 4; ++m) {
                const int row = u.pm * 256 + ai * 128 + wr * 64 + m * 16 + fr;
                const f32x4* pp = (const f32x4*)(part + (size_t)row * 32 + fq * 8);
                const f32x4 t0 = pp[0], t1 = pp[1];
                float ss = ((t0[0] + t0[1]) + (t0[2] + t0[3])) + ((t1[0] + t1[1]) + (t1[2] + t1[3]));
                ss += __shfl_xor(ss, 16); ss += __shfl_xor(ss, 32);
                const float rs = rsqrtf(ss * (1.0f / DM) + EPS);
                const f32x4 g0 = acc[ai][0][m][0] * rs, g1 = acc[ai][0][m][1] * rs, u0 = acc[ai][1][m][0] * rs, u1 = acc[ai][1][m][1] * rs;
                v4u w; w.x = pk2(siluf_(g0[0]) * u0[0], siluf_(g0[1]) * u0[1]); w.y = pk2(siluf_(g0[2]) * u0[2], siluf_(g0[3]) * u0[3]);
                w.z = pk2(siluf_(g1[0]) * u1[0], siluf_(g1[1]) * u1[1]); w.w = pk2(siluf_(g1[2]) * u1[2], siluf_(g1[3]) * u1[3]);
                *(v4u*)(ACT + (size_t)row * DFF + u.pn * 128 + wc * 32 + 8 * fq) = w;
            }
    }
};
struct EpiDown {
    static constexpr bool PERM = true, AFTER_DRAIN = false;
    float* yp; float* ys; const bf16* X1B;
    __device__ __forceinline__ void operator()(const pg8::f32x4 (&acc)[2][2][4][2], const pg8::Unit& u, int wr, int wc, int fr, int fq) const {
#pragma unroll
        for (int ai = 0; ai < 2; ++ai)
#pragma unroll
            for (int m = 0; m < 4; ++m) {
                const int row = u.pm * 256 + ai * 128 + wr * 64 + m * 16 + fr;
                if (row < MTOK) {
                    float* yr = row < MP ? yp + (size_t)row * DM : ys + (size_t)(row - MP) * DM;
#pragma unroll
                    for (int bj = 0; bj < 2; ++bj) {
                        const int col = u.pn * 256 + bj * 128 + wc * 32 + 8 * fq;
                        const v4u xw = *(const v4u*)(X1B + (size_t)row * DM + col); float xf[8]; UNPACK8(xw, xf);
                        __builtin_nontemporal_store((f32x4){xf[0], xf[1], xf[2], xf[3]} + acc[ai][bj][m][0], (f32x4*)(yr + col));
                        __builtin_nontemporal_store((f32x4){xf[4], xf[5], xf[6], xf[7]} + acc[ai][bj][m][1], (f32x4*)(yr + col + 4));
                    }
                }
            }
    }
};

__device__ __forceinline__ int maprow(int mode, int n0) {
    if (mode == 1) return n0 < 6688 ? n0 : n0 + 224;
    if (mode == 2) return (n0 >> 7) * 256 + (n0 & 127);
    if (mode == 3) return (n0 >> 7) * 256 + 128 + (n0 & 127);
    return n0;
}
__device__ __forceinline__ void tr_item(const float* W, int K, int N, bf16* WT, const float* gain, int mode, LAS float* scr, int item, int lane) {
    const int nblk = N / 32, kb = item / nblk, nb = item % nblk, k0 = 64 * kb, n0 = 32 * nb;
#pragma unroll 8
    for (int i = 0; i < 32; ++i) { const int kk = 2 * i + (lane >> 5); float v = W[(size_t)(k0 + kk) * N + n0 + (lane & 31)]; if (gain) v *= gain[k0 + kk]; scr[kk * 33 + (lane & 31)] = v; }
    asm volatile("s_waitcnt lgkmcnt(0)" ::: "memory");
    const int c = lane & 7, d0 = maprow(mode, n0);
#pragma unroll
    for (int j = 0; j < 4; ++j) { const int n = (lane >> 3) + 8 * j; const LAS float* s = scr + (8 * c) * 33 + n;
        v4u o; o.x = pk2(s[0 * 33], s[1 * 33]); o.y = pk2(s[2 * 33], s[3 * 33]); o.z = pk2(s[4 * 33], s[5 * 33]); o.w = pk2(s[6 * 33], s[7 * 33]);
        *(v4u*)(WT + (size_t)(d0 + n) * K + k0 + 8 * c) = o; }
    asm volatile("s_waitcnt lgkmcnt(0)" ::: "memory");
}
__device__ __forceinline__ void tr_item64(const float* W, int K, int N, bf16* WT, const float* gain, int mode, LAS float* scr, int item, int lane) {
    const int nblk = (N + 63) / 64, kb = item / nblk, nb = item % nblk, k0 = 64 * kb, n0 = 64 * nb;
    const int c4 = (lane & 15) * 4; const bool colok = n0 + c4 < N;
#pragma unroll 8
    for (int i = 0; i < 16; ++i) { const int kk = 4 * i + (lane >> 4);
        f32x4 v = {0.f, 0.f, 0.f, 0.f}; if (colok) v = *(const f32x4*)(W + (size_t)(k0 + kk) * N + n0 + c4);
        if (gain) v = v * gain[k0 + kk];
        scr[kk * 65 + c4] = v[0]; scr[kk * 65 + c4 + 1] = v[1]; scr[kk * 65 + c4 + 2] = v[2]; scr[kk * 65 + c4 + 3] = v[3]; }
    asm volatile("s_waitcnt lgkmcnt(0)" ::: "memory");
    const int c = lane & 7, d0a = maprow(mode, n0), d0b = maprow(mode, n0 + 32);
#pragma unroll
    for (int j = 0; j < 8; ++j) { const int n = (lane >> 3) + 8 * j; const LAS float* s = scr + (8 * c) * 65 + n;
        if (n0 + n < N) { v4u o; o.x = pk2(s[0 * 65], s[1 * 65]); o.y = pk2(s[2 * 65], s[3 * 65]); o.z = pk2(s[4 * 65], s[5 * 65]); o.w = pk2(s[6 * 65], s[7 * 65]);
            const int drow = n < 32 ? d0a + n : d0b + (n - 32);
            *(v4u*)(WT + (size_t)drow * K + k0 + 8 * c) = o; } }
    asm volatile("s_waitcnt lgkmcnt(0)" ::: "memory");
}
__device__ __forceinline__ void row_to_bf16(const float* xrow, bf16* orow, float* rs, int lane) {
    f32x4 v[8]; float s = 0.f;
#pragma unroll
    for (int j = 0; j < 8; ++j) { v[j] = *((const f32x4*)xrow + lane + 64 * j); s += (v[j][0] * v[j][0] + v[j][1] * v[j][1]) + (v[j][2] * v[j][2] + v[j][3] * v[j][3]); }
    s = wave_sum(s);
    if (lane == 0) *rs = rsqrtf(s * (1.0f / DM) + EPS);
#pragma unroll
    for (int j = 0; j < 8; ++j) { v2u w; w.x = pk2(v[j][0], v[j][1]); w.y = pk2(v[j][2], v[j][3]); *((v2u*)orow + lane + 64 * j) = w; }
}
__device__ __forceinline__ void prologue(const KP& p, LAS unsigned char* lds) {
    const int tid = threadIdx.x, lane = tid & 63, wave = tid >> 6;
    const int gw = blockIdx.x * 8 + wave, NGW = gridDim.x * 8;
    unsigned char* ws = p.ws;
    LAS float* scr = (LAS float*)(lds + wave * 16640);
    constexpr int I_IN = 32 * 217, I_M = 32 * 32, I_S = 16 * 32;
    constexpr int NITEMS = I_IN + I_M + I_S + I_M + I_S + I_M;
    for (int it = gw; it < NITEMS; it += NGW) {
        int r = it;
        if (r < I_IN) { tr_item64(p.in[10], 2048, 13856, (bf16*)(ws + WS_WIN), p.in[9], 1, scr, r, lane); continue; } r -= I_IN;
        if (r < I_M) { tr_item64(p.in[21], 2048, 2048, (bf16*)(ws + WS_WM), p.in[20], 0, scr, r, lane); continue; } r -= I_M;
        if (r < I_S) { tr_item64(p.in[24], 1024, 2048, (bf16*)(ws + WS_WSWA), nullptr, 0, scr, r, lane); continue; } r -= I_S;
        if (r < I_M) { tr_item64(p.in[25], 2048, 2048, (bf16*)(ws + WS_WSSD), p.in[19], 0, scr, r, lane); continue; } r -= I_M;
        if (r < I_S) { tr_item64(p.in[26], 1024, 2048, (bf16*)(ws + WS_WMEM), nullptr, 0, scr, r, lane); continue; } r -= I_S;
        tr_item64(p.in[27], 2048, 2048, (bf16*)(ws + WS_WOUT), nullptr, 0, scr, r, lane);
    }
    { v4u* z = (v4u*)((bf16*)(ws + WS_WIN) + (size_t)6688 * 2048); const int nz = 224 * 2048 / 8; const v4u zero = {0u, 0u, 0u, 0u};
      for (int i = blockIdx.x * 512 + tid; i < nz; i += gridDim.x * 512) z[i] = zero; }
    bf16* XB = (bf16*)(ws + WS_XB); float* RS1 = (float*)(ws + WS_RS1);
    for (int r = gw; r < MPAD; r += NGW) {
        if (r < MTOK) { const float* src = r < MP ? p.in[0] + (size_t)r * DM : p.in[1] + (size_t)(r - MP) * DM; row_to_bf16(src, XB + (size_t)r * DM, RS1 + r, lane); }
        else { const v2u zero = {0u, 0u};
#pragma unroll
            for (int j = 0; j < 8; ++j) *((v2u*)(XB + (size_t)r * DM) + lane + 64 * j) = zero;
            if (lane == 0) RS1[r] = 0.f; }
    }
    bf16* MB = (bf16*)(ws + WS_MB); float* RSM = (float*)(ws + WS_RSM);
    for (int r = gw; r < 4096; r += NGW) row_to_bf16(p.in[8] + (size_t)r * DM, MB + (size_t)r * DM, RSM + r, lane);
}

__device__ __forceinline__ void late_weights(const KP& p, LAS unsigned char* lds) {
    const int tid = threadIdx.x, lane = tid & 63, wave = tid >> 6;
    const int gw = blockIdx.x * 8 + wave, NGW = gridDim.x * 8;
    unsigned char* ws = p.ws;
    LAS float* scr = (LAS float*)(lds + wave * 16640);
    constexpr int I_G = 32 * 88, I_D = 88 * 32;
    for (int it = gw; it < 2 * I_G + I_D; it += NGW) {
        int r = it;
        if (r < I_G) { tr_item64(p.in[29], 2048, DFF, (bf16*)(ws + WS_WGU), p.in[28], 2, scr, r, lane); continue; } r -= I_G;
        if (r < I_G) { tr_item64(p.in[30], 2048, DFF, (bf16*)(ws + WS_WGU), p.in[28], 3, scr, r, lane); continue; } r -= I_G;
        tr_item64(p.in[31], DFF, 2048, (bf16*)(ws + WS_WD), nullptr, 0, scr, r, lane);
    }
}
__device__ __forceinline__ void conv_prepass(const KP& p) {
    const bf16* PA = (const bf16*)(p.ws + WS_BIG);
    bf16* XCx = (bf16*)(p.ws + WS_XCX); bf16* XCbc = (bf16*)(p.ws + WS_XCBC);
    const int gthreads = gridDim.x * 512;
    for (int task = blockIdx.x * 512 + threadIdx.x; task < NBATCH * 64 * 384; task += gthreads) {
        const int cgp = task % 384, strip = (task / 384) & 63, b = task / (384 * 64);
        const int ch0 = cgp * 8;
        float cw0[8], cw1[8], cw2[8], cw3[8], cbv[8];
#pragma unroll
        for (int e = 0; e < 8; ++e) { cw0[e] = p.in[14][ch0 + e]; cw1[e] = p.in[14][CONVCH + ch0 + e]; cw2[e] = p.in[14][2 * CONVCH + ch0 + e]; cw3[e] = p.in[14][3 * CONVCH + ch0 + e]; cbv[e] = p.in[15][ch0 + e]; }
        const bf16* src = PA + (size_t)(b * SEQ) * NA + CXBC + ch0;
        bf16* dst = ch0 < 2048 ? XCx + (size_t)(b * SEQ) * 2048 + ch0 : XCbc + (size_t)(b * SEQ) * 1024 + (ch0 - 2048);
        const int ldd = ch0 < 2048 ? 2048 : 1024;
        const int t0 = strip * 32;
        float r0[8], r1[8], r2[8];
        {   v4u z0 = {0u, 0u, 0u, 0u}, z1 = z0, z2 = z0;
            if (t0 > 0) { z0 = *(const v4u*)(src + (size_t)(t0 - 3) * NA); z1 = *(const v4u*)(src + (size_t)(t0 - 2) * NA); z2 = *(const v4u*)(src + (size_t)(t0 - 1) * NA); }
            UNPACK8(z0, r0); UNPACK8(z1, r1); UNPACK8(z2, r2); }
#pragma unroll 8
        for (int l = 0; l < 32; ++l) {
            const v4u zc = *(const v4u*)(src + (size_t)(t0 + l) * NA);
            float cur[8], ov[8]; UNPACK8(zc, cur);
#pragma unroll
            for (int e = 0; e < 8; ++e) { const float v = cw0[e] * r0[e] + cw1[e] * r1[e] + cw2[e] * r2[e] + cw3[e] * cur[e] + cbv[e]; ov[e] = siluf_(v); r0[e] = r1[e]; r1[e] = r2[e]; r2[e] = cur[e]; }
            v4u o; o.x = pk2(ov[0], ov[1]); o.y = pk2(ov[2], ov[3]); o.z = pk2(ov[4], ov[5]); o.w = pk2(ov[6], ov[7]);
            *(v4u*)(dst + (size_t)(t0 + l) * ldd) = o;
        }
        if (strip == 63) {
            float* d = p.out + O_PCONV + (size_t)(b * 3) * CONVCH + ch0;
            *(f32x4*)d = (f32x4){r0[0], r0[1], r0[2], r0[3]}; *(f32x4*)(d + 4) = (f32x4){r0[4], r0[5], r0[6], r0[7]};
            *(f32x4*)(d + CONVCH) = (f32x4){r1[0], r1[1], r1[2], r1[3]}; *(f32x4*)(d + CONVCH + 4) = (f32x4){r1[4], r1[5], r1[6], r1[7]};
            *(f32x4*)(d + 2 * CONVCH) = (f32x4){r2[0], r2[1], r2[2], r2[3]}; *(f32x4*)(d + 2 * CONVCH + 4) = (f32x4){r2[4], r2[5], r2[6], r2[7]};
        }
    }
}

#define LDSP(T, off) ((LAS T*)(lds + (off)))
typedef short v4i16_t __attribute__((ext_vector_type(4)));
__device__ __forceinline__ bf16x8 tr_frag(LAS bf16* a0, LAS bf16* a1) {
    const v4i16_t lo = __builtin_amdgcn_ds_read_tr16_b64_v4i16((LAS v4i16_t*)a0), hi = __builtin_amdgcn_ds_read_tr16_b64_v4i16((LAS v4i16_t*)a1);
    bf16x8 r; r[0] = lo[0]; r[1] = lo[1]; r[2] = lo[2]; r[3] = lo[3]; r[4] = hi[0]; r[5] = hi[1]; r[6] = hi[2]; r[7] = hi[3]; return r;
}

__device__ __forceinline__ void swa_prompt_all(const KP& p, LAS unsigned char* lds, int first, int stride, int nitems) {
    const int tid = threadIdx.x, lane = tid & 63, w = tid >> 6, fr = lane & 15, fq = lane >> 4;
    LAS bf16* Qs = LDSP(bf16, 0);
    LAS bf16* Ks = LDSP(bf16, 18432);
    LAS bf16* Vs = LDSP(bf16, 57600);
    LAS bf16* Ps = LDSP(bf16, 96768) + w * (16 * 168);
    const bf16* PA = (const bf16*)(p.ws + WS_BIG);
    bf16* AO = (bf16*)((unsigned char*)(p.out + O_YP) + YP_AO);
    const int c = tid >> 1, half = tid & 1, qr = tid >> 2, qd = tid & 3;
    float kwv[32], qwv[16];
#pragma unroll
    for (int e = 0; e < 32; ++e) kwv[e] = p.in[12][half * 32 + e];
#pragma unroll
    for (int e = 0; e < 16; ++e) qwv[e] = p.in[11][qd * 16 + e] * 0.125f;
    v4u kz[4], vz[4], qz[2];
#define SWA_LOAD_KV(it_) do { const int kvh_ = (it_) & 3, blk_ = ((it_) >> 2) & 15, b_ = (it_) >> 6, s_ = (blk_ - 1) * 128 + c; \
        if (s_ >= 0) { const bf16* src_ = PA + (size_t)(b_ * SEQ + s_) * NA + kvh_ * 64 + half * 32; \
            _Pragma("unroll") for (int i = 0; i < 4; ++i) { kz[i] = *(const v4u*)(src_ + CK + i * 8); vz[i] = *(const v4u*)(src_ + CV + i * 8); } } \
        else { _Pragma("unroll") for (int i = 0; i < 4; ++i) { kz[i] = (v4u){0u, 0u, 0u, 0u}; vz[i] = (v4u){0u, 0u, 0u, 0u}; } } } while (0)
#define SWA_LOAD_Q(it_, hq_) do { const int kvh_ = (it_) & 3, blk_ = ((it_) >> 2) & 15, b_ = (it_) >> 6; \
        const bf16* qs_ = PA + (size_t)(b_ * SEQ + blk_ * 128 + qr) * NA + CQ + (kvh_ * 4 + (hq_)) * 64 + qd * 16; qz[0] = *(const v4u*)qs_; qz[1] = *(const v4u*)(qs_ + 8); } while (0)
    if (first < nitems) { SWA_LOAD_KV(first); SWA_LOAD_Q(first, 0); }
    for (int item = first; item < nitems; item += stride) {
      const int kvh = item & 3, blk = (item >> 2) & 15, b = item >> 6;
_Pragma("nounroll")
      for (int hq = 0; hq < 4; ++hq) {
        const int h = kvh * 4 + hq;
        if (hq == 0) {
            float kf[32];
#pragma unroll
            for (int i = 0; i < 4; ++i) { float t[8]; UNPACK8(kz[i], t);
#pragma unroll
                for (int e = 0; e < 8; ++e) kf[i * 8 + e] = t[e]; }
            float ss = 0.f;
#pragma unroll
            for (int e = 0; e < 32; ++e) ss += kf[e] * kf[e];
            ss += __shfl_xor(ss, 1);
            const float rs = rsqrtf(ss * (1.0f / 64.0f) + EPS);
#pragma unroll
            for (int e = 0; e < 32; ++e) kf[e] = kf[e] * rs * kwv[e];
#pragma unroll
            for (int i = 0; i < 4; ++i) { v4u o; o.x = pk2(kf[i * 8 + 0], kf[i * 8 + 1]); o.y = pk2(kf[i * 8 + 2], kf[i * 8 + 3]); o.z = pk2(kf[i * 8 + 4], kf[i * 8 + 5]); o.w = pk2(kf[i * 8 + 6], kf[i * 8 + 7]);
                *(LAS v4u*)(Ks + c * 72 + half * 32 + i * 8) = o; }
#pragma unroll
            for (int i = 0; i < 4; ++i) *(LAS v4u*)(Vs + c * 72 + half * 32 + i * 8) = vz[i];
            if (blk == 15 && c >= 128) {
                float* dk = p.out + O_PK + ((size_t)(b * 128 + (c - 128)) * 4 + kvh) * 64 + half * 32;
                float* dv = p.out + O_PV + ((size_t)(b * 128 + (c - 128)) * 4 + kvh) * 64 + half * 32;
#pragma unroll
                for (int i = 0; i < 4; ++i) { float t[8]; UNPACK8(vz[i], t);
                    *(f32x4*)(dk + i * 8) = (f32x4){kf[i * 8], kf[i * 8 + 1], kf[i * 8 + 2], kf[i * 8 + 3]}; *(f32x4*)(dk + i * 8 + 4) = (f32x4){kf[i * 8 + 4], kf[i * 8 + 5], kf[i * 8 + 6], kf[i * 8 + 7]};
                    *(f32x4*)(dv + i * 8) = (f32x4){t[0], t[1], t[2], t[3]}; *(f32x4*)(dv + i * 8 + 4) = (f32x4){t[4], t[5], t[6], t[7]}; }
            }
        }
        if (hq == 0) {
            if (tid >= 256 && tid < 400) *(LAS v4u*)(Vs + 256 * 72 + (tid - 256) * 8) = (v4u){0u, 0u, 0u, 0u};
            if (item + stride < nitems) SWA_LOAD_KV(item + stride);
        }
        {
            float qf[16]; { float t[8]; UNPACK8(qz[0], t);
#pragma unroll
                for (int e = 0; e < 8; ++e) qf[e] = t[e];
                UNPACK8(qz[1], t);
#pragma unroll
                for (int e = 0; e < 8; ++e) qf[8 + e] = t[e]; }
            float ss = 0.f;
#pragma unroll
            for (int e = 0; e < 16; ++e) ss += qf[e] * qf[e];
            ss += __shfl_xor(ss, 1); ss += __shfl_xor(ss, 2);
            const float rs = rsqrtf(ss * (1.0f / 64.0f) + EPS);
#pragma unroll
            for (int e = 0; e < 16; ++e) qf[e] = qf[e] * rs * qwv[e];
            v4u o0, o1; o0.x = pk2(qf[0], qf[1]); o0.y = pk2(qf[2], qf[3]); o0.z = pk2(qf[4], qf[5]); o0.w = pk2(qf[6], qf[7]);
            o1.x = pk2(qf[8], qf[9]); o1.y = pk2(qf[10], qf[11]); o1.z = pk2(qf[12], qf[13]); o1.w = pk2(qf[14], qf[15]);
            *(LAS v4u*)(Qs + qr * 72 + qd * 16) = o0; *(LAS v4u*)(Qs + qr * 72 + qd * 16 + 8) = o1;
        }
        if (hq < 3) SWA_LOAD_Q(item, hq + 1); else if (item + stride < nitems) SWA_LOAD_Q(item + stride, 0);
        LBAR();
        bf16x8 aq[2];
#pragma unroll
        for (int ks = 0; ks < 2; ++ks) aq[ks] = *(LAS bf16x8*)(Qs + (16 * w + fr) * 72 + ks * 32 + fq * 8);
        f32x4 sc[9];
#pragma unroll
        for (int i = 0; i < 9; ++i) { sc[i] = (f32x4){0.f, 0.f, 0.f, 0.f};
#pragma unroll
            for (int ks = 0; ks < 2; ++ks) { const bf16x8 bk = *(LAS bf16x8*)(Ks + ((w + i) * 16 + fr) * 72 + ks * 32 + fq * 8); sc[i] = mfma16(aq[ks], bk, sc[i]); } }
        const float slope = exp2f(-0.5f * (float)(h + 1)), sink = p.in[13][h];
#pragma unroll
        for (int j = 0; j < 4; ++j) {
            const int d = 4 * fq + j - fr; const float sd = slope * (float)d; const bool le0 = d <= 0, ge0 = d >= 0;
            float mx = -INFINITY;
#pragma unroll
            for (int i = 0; i < 9; ++i) { bool ok = (w + i <= 15) && (blk > 0 || w + i >= 8);
                if (i == 0) ok = ok && le0; if (i == 8) ok = ok && ge0;
                const float v = ok ? sc[i][j] - (slope * (float)(128 - 16 * i) + sd) : -INFINITY; sc[i][j] = v; mx = fmaxf(mx, v); }
            mx = fmaxf(mx, __shfl_xor(mx, 1)); mx = fmaxf(mx, __shfl_xor(mx, 2)); mx = fmaxf(mx, __shfl_xor(mx, 4)); mx = fmaxf(mx, __shfl_xor(mx, 8));
            mx = fmaxf(mx, sink);
            float sum = 0.f;
#pragma unroll
            for (int i = 0; i < 9; ++i) { const float e2 = __expf(sc[i][j] - mx); sc[i][j] = e2; sum += e2; }
            sum += __shfl_xor(sum, 1); sum += __shfl_xor(sum, 2); sum += __shfl_xor(sum, 4); sum += __shfl_xor(sum, 8);
            const float inv = 1.0f / (sum + __expf(sink - mx));
#pragma unroll
            for (int i = 0; i < 9; ++i) Ps[(fq * 4 + j) * 168 + i * 16 + fr] = (bf16)f2bf(sc[i][j] * inv);
            Ps[(fq * 4 + j) * 168 + 9 * 16 + fr] = (bf16)0;
        }
        asm volatile("s_waitcnt lgkmcnt(0)" ::: "memory");
        f32x4 o[4];
#pragma unroll
        for (int nt = 0; nt < 4; ++nt) o[nt] = (f32x4){0.f, 0.f, 0.f, 0.f};
#pragma unroll
        for (int ks = 0; ks < 5; ++ks) { const bf16x8 a = *(LAS bf16x8*)(Ps + fr * 168 + ks * 32 + fq * 8);
            LAS bf16* tb = Vs + (w * 16 + ks * 32 + fq * 8 + (fr >> 2)) * 72 + (fr & 3) * 4;
#pragma unroll
            for (int nt = 0; nt < 4; ++nt) { const bf16x8 bv = tr_frag(tb + nt * 16, tb + 4 * 72 + nt * 16); o[nt] = mfma16(a, bv, o[nt]); } }
#pragma unroll
        for (int j = 0; j < 4; ++j) { bf16* dst = AO + (size_t)(b * SEQ + blk * 128 + 16 * w + fq * 4 + j) * 1024 + h * 64 + fr;
#pragma unroll
            for (int nt = 0; nt < 4; ++nt) dst[nt * 16] = (bf16)f2bf(o[nt][j]); }
        LBAR();
      }
    }
#undef SWA_LOAD_KV
#undef SWA_LOAD_Q
}

__device__ __forceinline__ void mem_prompt_item(const KP& p, LAS unsigned char* lds, int item) {
    const int tid = threadIdx.x, lane = tid & 63, w = tid >> 6, fr = lane & 15, fq = lane >> 4;
    const int qt = item & 15, h = (item >> 4) & 3, b = item >> 6;
    LAS bf16* Qc = LDSP(bf16, 0);
    LAS bf16* Kc = LDSP(bf16, 18432);
    LAS bf16* Vs = LDSP(bf16, 0);
    LAS bf16* Ps = LDSP(bf16, 55296) + w * (16 * 264);
    LAS float* rq = LDSP(float, 122880); LAS float* rk = LDSP(float, 123392);
    const bf16* PA = (const bf16*)(p.ws + WS_BIG);
    const bf16* MKV = (const bf16*)(p.ws + WS_MKV);
    bf16* MO = (bf16*)(p.ws + WS_MO);
    const float* qw = p.in[22];
    float ssq_q = 0.f;
    f32x4 sc[16];
#pragma unroll
    for (int i = 0; i < 16; ++i) sc[i] = (f32x4){0.f, 0.f, 0.f, 0.f};
    const bf16* qsrc = PA + (size_t)(b * SEQ + qt * 128 + (tid >> 2)) * NA + CQM + h * 256 + (tid & 3) * 16;
    const bf16* ksrc = MKV + (size_t)(b * 256 + (tid >> 1)) * 2048 + h * 256 + (tid & 1) * 32;
    v4u pq[2], pkv[4];
    pq[0] = *(const v4u*)qsrc; pq[1] = *(const v4u*)(qsrc + 8);
#pragma unroll
    for (int i = 0; i < 4; ++i) pkv[i] = *(const v4u*)(ksrc + i * 8);
    for (int dc = 0; dc < 4; ++dc) {
        {   const int r = tid >> 2, qd = tid & 3;
            float qf[16]; { float t[8]; UNPACK8(pq[0], t);
#pragma unroll
                for (int e = 0; e < 8; ++e) qf[e] = t[e];
                UNPACK8(pq[1], t);
#pragma unroll
                for (int e = 0; e < 8; ++e) qf[8 + e] = t[e]; }
            { const f32x4 g0 = *(const f32x4*)(qw + dc * 64 + qd * 16), g1 = *(const f32x4*)(qw + dc * 64 + qd * 16 + 4), g2 = *(const f32x4*)(qw + dc * 64 + qd * 16 + 8), g3 = *(const f32x4*)(qw + dc * 64 + qd * 16 + 12);
              const float gq[16] = {g0[0], g0[1], g0[2], g0[3], g1[0], g1[1], g1[2], g1[3], g2[0], g2[1], g2[2], g2[3], g3[0], g3[1], g3[2], g3[3]};
#pragma unroll
              for (int e = 0; e < 16; ++e) { ssq_q += qf[e] * qf[e]; qf[e] *= gq[e]; } }
            v4u o0, o1; o0.x = pk2(qf[0], qf[1]); o0.y = pk2(qf[2], qf[3]); o0.z = pk2(qf[4], qf[5]); o0.w = pk2(qf[6], qf[7]);
            o1.x = pk2(qf[8], qf[9]); o1.y = pk2(qf[10], qf[11]); o1.z = pk2(qf[12], qf[13]); o1.w = pk2(qf[14], qf[15]);
            *(LAS v4u*)(Qc + r * 72 + qd * 16) = o0; *(LAS v4u*)(Qc + r * 72 + qd * 16 + 8) = o1;
        }
        {   const int c = tid >> 1, half = tid & 1;
#pragma unroll
            for (int i = 0; i < 4; ++i) *(LAS v4u*)(Kc + c * 72 + half * 32 + i * 8) = pkv[i];
        }
        if (dc < 3) { pq[0] = *(const v4u*)(qsrc + (dc + 1) * 64); pq[1] = *(const v4u*)(qsrc + (dc + 1) * 64 + 8);
#pragma unroll
            for (int i = 0; i < 4; ++i) pkv[i] = *(const v4u*)(ksrc + (dc + 1) * 64 + i * 8); }
        else {
#pragma unroll
            for (int i = 0; i < 4; ++i) pkv[i] = *(const v4u*)(ksrc + 1024 + i * 8); }
        LBAR();
        bf16x8 aq[2];
#pragma unroll
        for (int ks = 0; ks < 2; ++ks) aq[ks] = *(LAS bf16x8*)(Qc + (16 * w + fr) * 72 + ks * 32 + fq * 8);
#pragma unroll
        for (int i = 0; i < 16; ++i)
#pragma unroll
            for (int ks = 0; ks < 2; ++ks) { const bf16x8 bk = *(LAS bf16x8*)(Kc + (i * 16 + fr) * 72 + ks * 32 + fq * 8); sc[i] = mfma16(aq[ks], bk, sc[i]); }
        LBAR();
    }
    ssq_q += __shfl_xor(ssq_q, 1); ssq_q += __shfl_xor(ssq_q, 2);
    if ((tid & 3) == 0) rq[tid >> 2] = rsqrtf(ssq_q * (1.0f / 256.0f) + EPS);
    LBAR();
    {
#pragma unroll
        for (int j = 0; j < 4; ++j) {
            const float rqv = rq[16 * w + fq * 4 + j] * 0.0625f;
            float mx = -INFINITY;
#pragma unroll
            for (int i = 0; i < 16; ++i) { const float v = sc[i][j] * rqv; sc[i][j] = v; mx = fmaxf(mx, v); }
            mx = fmaxf(mx, __shfl_xor(mx, 1)); mx = fmaxf(mx, __shfl_xor(mx, 2)); mx = fmaxf(mx, __shfl_xor(mx, 4)); mx = fmaxf(mx, __shfl_xor(mx, 8));
            float sum = 0.f;
#pragma unroll
            for (int i = 0; i < 16; ++i) { const float e = __expf(sc[i][j] - mx); sc[i][j] = e; sum += e; }
            sum += __shfl_xor(sum, 1); sum += __shfl_xor(sum, 2); sum += __shfl_xor(sum, 4); sum += __shfl_xor(sum, 8);
            const float inv = 1.0f / sum;
#pragma unroll
            for (int i = 0; i < 16; ++i) Ps[(fq * 4 + j) * 264 + i * 16 + fr] = (bf16)f2bf(sc[i][j] * inv);
        }
    }
    for (int dc = 0; dc < 4; ++dc) {
        {   const int c = tid >> 1, half = tid & 1;
#pragma unroll
            for (int i = 0; i < 4; ++i) *(LAS v4u*)(Vs + c * 72 + half * 32 + i * 8) = pkv[i];
            if (dc < 3) {
#pragma unroll
                for (int i = 0; i < 4; ++i) pkv[i] = *(const v4u*)(ksrc + 1024 + (dc + 1) * 64 + i * 8); }
        }
        LBAR();
        f32x4 o[4];
#pragma unroll
        for (int nt = 0; nt < 4; ++nt) o[nt] = (f32x4){0.f, 0.f, 0.f, 0.f};
#pragma unroll
        for (int ks = 0; ks < 8; ++ks) { const bf16x8 a = *(LAS bf16x8*)(Ps + fr * 264 + ks * 32 + fq * 8);
            LAS bf16* tb = Vs + (ks * 32 + fq * 8 + (fr >> 2)) * 72 + (fr & 3) * 4;
#pragma unroll
            for (int nt = 0; nt < 4; ++nt) { const bf16x8 bv = tr_frag(tb + nt * 16, tb + 4 * 72 + nt * 16); o[nt] = mfma16(a, bv, o[nt]); } }
#pragma unroll
        for (int j = 0; j < 4; ++j) { bf16* dst = MO + (size_t)(b * SEQ + qt * 128 + 16 * w + fq * 4 + j) * 1024 + h * 256 + dc * 64 + fr;
#pragma unroll
            for (int nt = 0; nt < 4; ++nt) dst[nt * 16] = (bf16)f2bf(o[nt][j]); }
        LBAR();
    }
}

__device__ __forceinline__ void memk_norm_pass(const KP& p) {
    const int lane = threadIdx.x & 63, gw = blockIdx.x * 8 + (threadIdx.x >> 6), NGW = gridDim.x * 8;
    bf16* MKV = (bf16*)(p.ws + WS_MKV);
    const f32x4 g = *(const f32x4*)(p.in[23] + lane * 4);
    for (int sg = gw; sg < 4096 * 4; sg += NGW) { const int row = sg >> 2, h = sg & 3;
        v2u* kp = (v2u*)(MKV + (size_t)row * 2048 + h * 256 + lane * 4);
        const v2u kz = *kp; const float k0 = lo16(kz.x), k1 = hi16(kz.x), k2 = lo16(kz.y), k3 = hi16(kz.y);
        const float rs = rsqrtf(wave_sum((k0 * k0 + k1 * k1) + (k2 * k2 + k3 * k3)) * (1.0f / 256.0f) + EPS);
        const f32x4 kn = {k0 * rs * g[0], k1 * rs * g[1], k2 * rs * g[2], k3 * rs * g[3]};
        v2u o; o.x = pk2(kn[0], kn[1]); o.y = pk2(kn[2], kn[3]); *kp = o;
        *(f32x4*)(p.out + O_PMK + (size_t)row * 1024 + h * 256 + lane * 4) = kn; }
}

__device__ __forceinline__ float softplusf_(float x) { return x > 20.f ? x : log1pf(__expf(x)); }
__device__ __forceinline__ void ssd_prompt_item(const KP& p, LAS unsigned char* lds, int b, int head) {
    const int tid = threadIdx.x, lane = tid & 63, w = tid >> 6, fr = lane & 15, fq = lane >> 4;
    const int g = head >> 3;
    const int rt = w < 4 ? w : 11 - w;
    LAS bf16* Xs = LDSP(bf16, 0);
    LAS bf16* Bs = LDSP(bf16, 18432);
    LAS bf16* Cs = LDSP(bf16, 53248);
    LAS bf16* HsT = LDSP(bf16, 88064);
    LAS float* dtv = LDSP(float, 106496); LAS float* acs = LDSP(float, 107008); LAS float* das = LDSP(float, 107520); LAS float* coefv = LDSP(float, 108032);
    const bf16* PA = (const bf16*)(p.ws + WS_BIG);
    const bf16* XCx = (const bf16*)(p.ws + WS_XCX); const bf16* XCbc = (const bf16*)(p.ws + WS_XCBC);
    const float* DT = (const float*)(p.ws + WS_DT);
    float* SSQ = (float*)(p.ws + WS_SSQ);
    bf16* SO = (bf16*)((unsigned char*)(p.out + O_YP) + YP_SO);
    const float dtb = p.in[16][head], Aneg = -__expf(p.in[17][head]), Dh = p.in[18][head];
    f32x4 hst[4];
#pragma unroll
    for (int i = 0; i < 4; ++i) hst[i] = (f32x4){0.f, 0.f, 0.f, 0.f};
    const int pt = w & 3, nb0 = (w >> 2) * 4;
    const int tq = fr >> 2, tp = (fr & 3) * 4;
    const bf16* srcB = XCbc + (size_t)(b * SEQ + (tid >> 4)) * 1024 + g * 128 + (tid & 15) * 8;
    const bf16* srcX = XCx + (size_t)(b * SEQ + (tid >> 3)) * 2048 + head * 64 + (tid & 7) * 8;
    v4u pfB[4], pfC[4], pfX[2]; float pfdt = 0.f;
#pragma unroll
    for (int i = 0; i < 4; ++i) { pfB[i] = *(const v4u*)(srcB + (size_t)(32 * i) * 1024); pfC[i] = *(const v4u*)(srcB + (size_t)(32 * i) * 1024 + 512); }
#pragma unroll
    for (int i = 0; i < 2; ++i) pfX[i] = *(const v4u*)(srcX + (size_t)(64 * i) * 2048);
    if (tid < 128) pfdt = DT[(size_t)(b * SEQ + tid) * 32 + head];
    for (int c = 0; c < 16; ++c) {
        const int t0 = c * 128;
#pragma unroll
        for (int i = 0; i < 4; ++i) { *(LAS v4u*)(Bs + ((tid >> 4) + 32 * i) * 136 + (tid & 15) * 8) = pfB[i]; *(LAS v4u*)(Cs + ((tid >> 4) + 32 * i) * 136 + (tid & 15) * 8) = pfC[i]; }
#pragma unroll
        for (int i = 0; i < 2; ++i) *(LAS v4u*)(Xs + ((tid >> 3) + 64 * i) * 72 + (tid & 7) * 8) = pfX[i];
        if (tid < 128) { const float dt = softplusf_(pfdt + dtb); dtv[tid] = dt; das[tid] = dt * Aneg; }
#pragma unroll
        for (int i = 0; i < 4; ++i) { v2u hw; hw.x = pk2(hst[i][0], hst[i][1]); hw.y = pk2(hst[i][2], hst[i][3]);
            *(LAS v2u*)(HsT + ((nb0 + i) * 16 + fr) * 72 + pt * 16 + fq * 4) = hw; }
        unsigned short zr[16];
#pragma unroll
        for (int j = 0; j < 4; ++j)
#pragma unroll
            for (int nt = 0; nt < 4; ++nt) zr[j * 4 + nt] = PA[(size_t)(b * SEQ + t0 + 16 * rt + fq * 4 + j) * NA + CZ + head * 64 + nt * 16 + fr];
        if (c < 15) {
#pragma unroll
            for (int i = 0; i < 4; ++i) { pfB[i] = *(const v4u*)(srcB + (size_t)(t0 + 128 + 32 * i) * 1024); pfC[i] = *(const v4u*)(srcB + (size_t)(t0 + 128 + 32 * i) * 1024 + 512); }
#pragma unroll
            for (int i = 0; i < 2; ++i) pfX[i] = *(const v4u*)(srcX + (size_t)(t0 + 128 + 64 * i) * 2048);
            if (tid < 128) pfdt = DT[(size_t)(b * SEQ + t0 + 128 + tid) * 32 + head];
        }
        LBAR();
        {
            const float a0 = das[2 * lane], a1 = das[2 * lane + 1]; float s = a0 + a1;
#pragma unroll
            for (int off = 1; off < 64; off <<= 1) { const float t = __shfl_up(s, off); if (lane >= off) s += t; }
            acs[2 * lane + 1] = s; acs[2 * lane] = s - a1;
            const float tot = __shfl(s, 63); coefv[2 * lane] = __expf(tot - (s - a1)) * dtv[2 * lane]; coefv[2 * lane + 1] = __expf(tot - s) * dtv[2 * lane + 1]; }
        asm volatile("s_waitcnt lgkmcnt(0)" ::: "memory");
        bf16x8 ac[4];
#pragma unroll
        for (int ks = 0; ks < 4; ++ks) ac[ks] = *(LAS bf16x8*)(Cs + (16 * rt + fr) * 136 + ks * 32 + fq * 8);
        f32x4 yo[4], yd[4];
#pragma unroll
        for (int nt = 0; nt < 4; ++nt) { yo[nt] = (f32x4){0.f, 0.f, 0.f, 0.f}; yd[nt] = (f32x4){0.f, 0.f, 0.f, 0.f}; }
#pragma unroll
        for (int ks = 0; ks < 4; ++ks) { LAS bf16* hb = HsT + (ks * 32 + fq * 8 + tq) * 72 + tp;
#pragma unroll
            for (int nt = 0; nt < 4; ++nt) { const bf16x8 bh = tr_frag(hb + nt * 16, hb + 4 * 72 + nt * 16); yo[nt] = mfma16(ac[ks], bh, yo[nt]); } }
        const float alc = acs[16 * rt + fr];
#pragma unroll
        for (int ks = 0; ks < 4; ++ks) {
            if (2 * ks <= rt) {
                v4u wp = {0u, 0u, 0u, 0u};
#pragma unroll
                for (int hf = 0; hf < 2; ++hf) { const int nt = 2 * ks + hf;
                    if (nt <= rt) {
                        f32x4 cb = {0.f, 0.f, 0.f, 0.f};
#pragma unroll
                        for (int kk = 0; kk < 4; ++kk) { const bf16x8 bb = *(LAS bf16x8*)(Bs + (nt * 16 + fr) * 136 + kk * 32 + fq * 8); cb = mfma16(bb, ac[kk], cb); }
                        const f32x4 as4 = *(LAS f32x4*)(acs + nt * 16 + fq * 4), dt4 = *(LAS f32x4*)(dtv + nt * 16 + fq * 4);
                        float wv[4];
#pragma unroll
                        for (int j = 0; j < 4; ++j) { const bool keep = nt < rt || fq * 4 + j <= fr; wv[j] = keep ? cb[j] * __expf(alc - as4[j]) * dt4[j] : 0.f; }
                        if (hf == 0) { wp.x = pk2(wv[0], wv[1]); wp.y = pk2(wv[2], wv[3]); } else { wp.z = pk2(wv[0], wv[1]); wp.w = pk2(wv[2], wv[3]); }
                    }
                }
                const bf16x8 aw = __builtin_bit_cast(bf16x8, wp);
                LAS bf16* xb0 = Xs + (ks * 32 + fq * 4 + tq) * 72 + tp;
#pragma unroll
                for (int nt = 0; nt < 4; ++nt) { const bf16x8 bx = tr_frag(xb0 + nt * 16, xb0 + 16 * 72 + nt * 16); yd[nt] = mfma16(aw, bx, yd[nt]); }
            }
        }
        float al[4];
#pragma unroll
        for (int j = 0; j < 4; ++j) al[j] = acs[16 * rt + fq * 4 + j];
#pragma unroll
        for (int j = 0; j < 4; ++j) {
            const int l = 16 * rt + fq * 4 + j; const size_t tok = (size_t)(b * SEQ + t0 + l); const float el = __expf(al[j]);
            float ss = 0.f;
#pragma unroll
            for (int nt = 0; nt < 4; ++nt) { const int pp = nt * 16 + fr; const float xv = bf2f(Xs[l * 72 + pp]);
                const float y = yd[nt][j] + el * yo[nt][j] + Dh * xv;
                const float zv = bf2f(zr[j * 4 + nt]);
                const float yz = y * siluf_(zv); ss += yz * yz; SO[tok * 2048 + head * 64 + pp] = (bf16)f2bf(yz); }
            ss += __shfl_xor(ss, 1); ss += __shfl_xor(ss, 2); ss += __shfl_xor(ss, 4); ss += __shfl_xor(ss, 8);
            if (fr == 0) SSQ[tok * 32 + head] = ss;
        }
        const float aL = acs[127];
        f32x4 st[4];
#pragma unroll
        for (int i = 0; i < 4; ++i) st[i] = (f32x4){0.f, 0.f, 0.f, 0.f};
#pragma unroll
        for (int ks = 0; ks < 4; ++ks) {
            LAS bf16* xa = Xs + (ks * 32 + fq * 8 + tq) * 72 + pt * 16 + tp;
            const bf16x8 axr = tr_frag(xa, xa + 4 * 72);
            const v4u axw = __builtin_bit_cast(v4u, axr);
            float xf[8]; UNPACK8(axw, xf);
            { const f32x4 c0 = *(LAS f32x4*)(coefv + ks * 32 + fq * 8), c1 = *(LAS f32x4*)(coefv + ks * 32 + fq * 8 + 4);
              xf[0] *= c0[0]; xf[1] *= c0[1]; xf[2] *= c0[2]; xf[3] *= c0[3]; xf[4] *= c1[0]; xf[5] *= c1[1]; xf[6] *= c1[2]; xf[7] *= c1[3]; }
            v4u pw; pw.x = pk2(xf[0], xf[1]); pw.y = pk2(xf[2], xf[3]); pw.z = pk2(xf[4], xf[5]); pw.w = pk2(xf[6], xf[7]);
            const bf16x8 ax = __builtin_bit_cast(bf16x8, pw);
            LAS bf16* tb = Bs + (ks * 32 + fq * 8 + tq) * 136 + tp;
#pragma unroll
            for (int i = 0; i < 4; ++i) { const bf16x8 bb = tr_frag(tb + (nb0 + i) * 16, tb + 4 * 136 + (nb0 + i) * 16); st[i] = mfma16(ax, bb, st[i]); }
        }
        const float eL = __expf(aL);
#pragma unroll
        for (int i = 0; i < 4; ++i) hst[i] = hst[i] * eL + st[i];
        LBAR();
    }
#pragma unroll
    for (int i = 0; i < 4; ++i)
#pragma unroll
        for (int j = 0; j < 4; ++j) p.out[O_PSSM + ((size_t)(b * 32 + head) * 64 + pt * 16 + fq * 4 + j) * 128 + (nb0 + i) * 16 + fr] = hst[i][j];
}
template <int NB> __device__ __forceinline__ void skinny_core(LAS unsigned char* lds, const bf16* A, const bf16* Bt, const int (&brow)[NB], int K, f32x4 (&out)[NB]) {
    const int lane = threadIdx.x & 63, w = threadIdx.x >> 6, fr = lane & 15, fq = lane >> 4;
    const int ksw = K >> 8;
    const bf16* ap = A + (size_t)fr * K + (size_t)w * ksw * 32 + fq * 8;
    const bf16* bp[NB];
    f32x4 acc[8][NB];
#pragma unroll
    for (int nb = 0; nb < NB; ++nb) { bp[nb] = Bt + (size_t)(brow[nb] + fr) * K + (size_t)w * ksw * 32 + fq * 8;
#pragma unroll
        for (int rt = 0; rt < 8; ++rt) acc[rt][nb] = (f32x4){0.f, 0.f, 0.f, 0.f}; }
#pragma unroll 2
    for (int s = 0; s < ksw; ++s) {
        bf16x8 bfr[NB];
#pragma unroll
        for (int nb = 0; nb < NB; ++nb) bfr[nb] = *(const bf16x8*)(bp[nb] + s * 32);
#pragma unroll
        for (int rt = 0; rt < 8; ++rt) { const bf16x8 a = *(const bf16x8*)(ap + (size_t)(rt * 16) * K + s * 32);
#pragma unroll
            for (int nb = 0; nb < NB; ++nb) acc[rt][nb] = mfma16(a, bfr[nb], acc[rt][nb]); }
    }
    LAS f32x4* red = (LAS f32x4*)lds;
#pragma unroll
    for (int rt = 0; rt < 8; ++rt)
#pragma unroll
        for (int nb = 0; nb < NB; ++nb) red[((w * 8 + rt) * NB + nb) * 64 + lane] = acc[rt][nb];
    LBAR();
#pragma unroll
    for (int nb = 0; nb < NB; ++nb) { f32x4 s = red[((0 * 8 + w) * NB + nb) * 64 + lane];
#pragma unroll
        for (int w2 = 1; w2 < 8; ++w2) s += red[((w2 * 8 + w) * NB + nb) * 64 + lane];
        out[nb] = s; }
    LBAR();
}
#define SK_ROWCOL const int lane_ = threadIdx.x & 63, w_ = threadIdx.x >> 6, fr_ = lane_ & 15, fq_ = lane_ >> 4
template <int ACT> __device__ __forceinline__ void skinny_proj(LAS unsigned char* lds, const bf16* A, const bf16* Bt, int N, int K, bf16* O, int ldc, const float* rs, float* f32o, int fc0, int fw, int fld) {
    SK_ROWCOL;
    for (int u = blockIdx.x; u < N / 32; u += gridDim.x) {
        const int br[2] = {u * 32, u * 32 + 16}; f32x4 acc[2];
        skinny_core<2>(lds, A, Bt, br, K, acc);
#pragma unroll
        for (int j = 0; j < 4; ++j) { const int row = MP + 16 * w_ + 4 * fq_ + j; const float s = rs[row];
#pragma unroll
            for (int nt = 0; nt < 2; ++nt) { const int col = u * 32 + nt * 16 + fr_; float v = acc[nt][j] * s; if (ACT == 1) v = sigmoidf_(v);
                O[(size_t)row * ldc + col] = (bf16)f2bf(v);
                if (f32o && col >= fc0 && col < fc0 + fw) f32o[(size_t)row * fld + col - fc0] = v; } }
    }
}
template <int ACCUM> __device__ __forceinline__ void skinny_merge(LAS unsigned char* lds, const bf16* A, const bf16* Bt, int K, bf16* MG, const bf16* G) {
    SK_ROWCOL;
    for (int u = blockIdx.x; u < 2048 / 16; u += gridDim.x) {
        const int br[1] = {u * 16}; f32x4 acc[1];
        skinny_core<1>(lds, A, Bt, br, K, acc);
#pragma unroll
        for (int j = 0; j < 4; ++j) { const int row = MP + 16 * w_ + 4 * fq_ + j, col = u * 16 + fr_;
            float v = bf2f(G[(size_t)row * NG + col]) * acc[0][j];
            if (ACCUM) v += bf2f(MG[(size_t)row * 2048 + col]);
            MG[(size_t)row * 2048 + col] = (bf16)f2bf(v); }
    }
}
__device__ __forceinline__ void skinny_wout(LAS unsigned char* lds, const bf16* A, const bf16* Bt, const float* xs, bf16* X1B, float* parts) {
    SK_ROWCOL;
    for (int u = blockIdx.x; u < 2048 / 32; u += gridDim.x) {
        const int br[2] = {u * 32, u * 32 + 16}; f32x4 acc[2];
        skinny_core<2>(lds, A, Bt, br, 2048, acc);
#pragma unroll
        for (int j = 0; j < 4; ++j) { const int r = 16 * w_ + 4 * fq_ + j; float ps = 0.f;
#pragma unroll
            for (int nt = 0; nt < 2; ++nt) { const int col = u * 32 + nt * 16 + fr_; const float v = xs[(size_t)r * DM + col] + acc[nt][j];
                X1B[(size_t)(MP + r) * DM + col] = (bf16)f2bf(v); ps += v * v; }
            ps += __shfl_xor(ps, 1); ps += __shfl_xor(ps, 2); ps += __shfl_xor(ps, 4); ps += __shfl_xor(ps, 8);
            if (fr_ == 0) parts[r * 64 + u] = ps; }
    }
}
__device__ __forceinline__ void skinny_ffn_up(LAS unsigned char* lds, const bf16* A, const bf16* Bt, const float* parts, bf16* ACT) {
    SK_ROWCOL;
    LAS float* rs2s = (LAS float*)(lds + 131072);
    if (threadIdx.x < 128) { const f32x4* pp = (const f32x4*)(parts + threadIdx.x * 64); float ss = 0.f;
#pragma unroll
        for (int i = 0; i < 16; ++i) { const f32x4 t = pp[i]; ss += (t[0] + t[1]) + (t[2] + t[3]); }
        rs2s[threadIdx.x] = rsqrtf(ss * (1.0f / DM) + EPS); }
    LBAR();
    for (int u = blockIdx.x; u < DFF / 16; u += gridDim.x) {
        const int j0 = u * 16, gr = (j0 >> 7) * 256 + (j0 & 127);
        const int br[2] = {gr, gr + 128}; f32x4 acc[2];
        skinny_core<2>(lds, A, Bt, br, 2048, acc);
#pragma unroll
        for (int j = 0; j < 4; ++j) { const int r = 16 * w_ + 4 * fq_ + j; const float rs = rs2s[r];
            ACT[(size_t)(MP + r) * DFF + j0 + fr_] = (bf16)f2bf(siluf_(acc[0][j] * rs) * (acc[1][j] * rs)); }
    }
}
__device__ __forceinline__ void skinny_down(LAS unsigned char* lds, const bf16* A, const bf16* Bt, float* ys, const bf16* X1B) {
    SK_ROWCOL;
    for (int u = blockIdx.x; u < 2048 / 16; u += gridDim.x) {
        const int br[1] = {u * 16}; f32x4 acc[1];
        skinny_core<1>(lds, A, Bt, br, DFF, acc);
#pragma unroll
        for (int j = 0; j < 4; ++j) { const int r = 16 * w_ + 4 * fq_ + j, col = u * 16 + fr_; ys[(size_t)r * DM + col] = bf2f(X1B[(size_t)(MP + r) * DM + col]) + acc[0][j]; }
    }
}

__device__ __forceinline__ void ssd_decode_item(const KP& p, LAS unsigned char* lds, int item) {
    const int tid = threadIdx.x, lane = tid & 63;
    const int head = item & 31, b = item >> 5, g = head >> 3;
    const size_t tok = (size_t)(MP + b);
    LAS float* xs = LDSP(float, 0); LAS float* Bv = LDSP(float, 256); LAS float* Cv = LDSP(float, 768); LAS float* red = LDSP(float, 1280);
    const bf16* PA = (const bf16*)(p.ws + WS_BIG);
    const float* DT = (const float*)(p.ws + WS_DT);
    float* SSQ = (float*)(p.ws + WS_SSQ);
    bf16* SO = (bf16*)((unsigned char*)(p.out + O_YP) + YP_SO);
    const int pp = tid >> 3, q = tid & 7;
    const size_t hoff = ((size_t)(b * 32 + head) * 64 + pp) * 128;
    f32x4 hv[4];
#pragma unroll
    for (int i = 0; i < 4; ++i) hv[i] = *(const f32x4*)(p.in[6] + hoff + q * 4 + 32 * i);
    const float dtraw = DT[tok * 32 + head];
    const unsigned short zraw = PA[tok * NA + CZ + head * 64 + pp];
    if (tid < 320) {
        const int ch = tid < 64 ? head * 64 + tid : (tid < 192 ? 2048 + g * 128 + (tid - 64) : 2560 + g * 128 + (tid - 192));
        const float raw = bf2f(PA[tok * NA + CXBC + ch]);
        const float s0 = p.in[7][(size_t)(b * 3 + 0) * CONVCH + ch], s1 = p.in[7][(size_t)(b * 3 + 1) * CONVCH + ch], s2 = p.in[7][(size_t)(b * 3 + 2) * CONVCH + ch];
        const float v = p.in[14][ch] * s0 + p.in[14][CONVCH + ch] * s1 + p.in[14][2 * CONVCH + ch] * s2 + p.in[14][3 * CONVCH + ch] * raw + p.in[15][ch];
        const float o = siluf_(v);
        if (tid < 64) xs[tid] = o; else if (tid < 192) Bv[tid - 64] = o; else Cv[tid - 192] = o;
        if (tid < 64 || (head & 7) == 0) { float* d = p.out + O_SCONV + (size_t)(b * 3) * CONVCH + ch; d[0] = s1; d[CONVCH] = s2; d[2 * CONVCH] = raw; }
    }
    LBAR();
    const float dt = softplusf_(dtraw + p.in[16][head]);
    const float dA = __expf(dt * (-__expf(p.in[17][head]))), Dh = p.in[18][head];
    const float xv = xs[pp], xdt = xv * dt;
    float part = 0.f, cbp = 0.f;
#pragma unroll
    for (int i = 0; i < 4; ++i) {
        const int n = q * 4 + 32 * i;
        const f32x4 bv = *(LAS f32x4*)(Bv + n), cv = *(LAS f32x4*)(Cv + n);
        part += (cv[0] * hv[i][0] + cv[1] * hv[i][1]) + (cv[2] * hv[i][2] + cv[3] * hv[i][3]);
        cbp += (cv[0] * bv[0] + cv[1] * bv[1]) + (cv[2] * bv[2] + cv[3] * bv[3]);
        __builtin_nontemporal_store(hv[i] * dA + bv * xdt, (f32x4*)(p.out + O_SSSM + hoff + n));
    }
    part += __shfl_xor(part, 1); part += __shfl_xor(part, 2); part += __shfl_xor(part, 4);
    cbp += __shfl_xor(cbp, 1); cbp += __shfl_xor(cbp, 2); cbp += __shfl_xor(cbp, 4);
    if (q == 0) {
        const float y = cbp * dt * xv + part * dA + Dh * xv;
        const float zv = bf2f(zraw);
        const float yz = y * siluf_(zv);
        SO[tok * 2048 + head * 64 + pp] = (bf16)f2bf(yz);
        red[pp] = yz * yz;
    }
    LBAR();
    if (tid < 64) { const float s = wave_sum(red[lane]); if (lane == 0) SSQ[tok * 32 + head] = s; }
    LBAR();
}

__device__ __forceinline__ void swa_decode_item(const KP& p, LAS unsigned char* lds, int item) {
    const int tid = threadIdx.x, lane = tid & 63, w = tid >> 6;
    const int kvh = item & 3, b = item >> 2;
    const size_t tok = (size_t)(MP + b);
    LAS float* Kf = LDSP(float, 0);
    LAS float* Vf = LDSP(float, 33792);
    LAS float* qn = LDSP(float, 66816);
    LAS float* sc = LDSP(float, 67840);
    const bf16* PA = (const bf16*)(p.ws + WS_BIG);
    bf16* AO = (bf16*)((unsigned char*)(p.out + O_YP) + YP_AO);
    for (int idx = tid; idx < 128 * 16; idx += 512) { const int j = idx >> 4, c4 = idx & 15;
        const size_t off = ((size_t)(b * 128 + j) * 4 + kvh) * 64 + c4 * 4;
        const f32x4 kv = *(const f32x4*)(p.in[2] + off), vv = *(const f32x4*)(p.in[3] + off);
        Kf[j * 65 + c4 * 4 + 0] = kv[0]; Kf[j * 65 + c4 * 4 + 1] = kv[1]; Kf[j * 65 + c4 * 4 + 2] = kv[2]; Kf[j * 65 + c4 * 4 + 3] = kv[3];
        *(LAS f32x4*)(Vf + j * 64 + c4 * 4) = vv;
        if (j >= 1) { const size_t o2 = ((size_t)(b * 128 + j - 1) * 4 + kvh) * 64 + c4 * 4; *(f32x4*)(p.out + O_SK + o2) = kv; *(f32x4*)(p.out + O_SV + o2) = vv; } }
    if (w == 0) { const float kr = bf2f(PA[tok * NA + CK + kvh * 64 + lane]); const float ss = wave_sum(kr * kr);
        const float kn = kr * rsqrtf(ss * (1.0f / 64.0f) + EPS) * p.in[12][lane];
        Kf[128 * 65 + lane] = kn; p.out[O_SK + ((size_t)(b * 128 + 127) * 4 + kvh) * 64 + lane] = kn; }
    else if (w == 1) { const float vr = bf2f(PA[tok * NA + CV + kvh * 64 + lane]); Vf[128 * 64 + lane] = vr; p.out[O_SV + ((size_t)(b * 128 + 127) * 4 + kvh) * 64 + lane] = vr; }
    else if (w < 6) { const int hq = w - 2; const float qr = bf2f(PA[tok * NA + CQ + (kvh * 4 + hq) * 64 + lane]); const float ss = wave_sum(qr * qr);
        qn[hq * 64 + lane] = qr * rsqrtf(ss * (1.0f / 64.0f) + EPS) * p.in[11][lane] * 0.125f; }
    LBAR();
    for (int idx = tid; idx < 4 * 129; idx += 512) { const int hq = idx / 129, j = idx % 129;
        float d = 0.f;
#pragma unroll 8
        for (int e = 0; e < 64; ++e) d += qn[hq * 64 + e] * Kf[j * 65 + e];
        const float slope = exp2f(-0.5f * (float)(kvh * 4 + hq + 1));
        sc[hq * 132 + j] = d - slope * (float)(128 - j); }
    LBAR();
    if (w < 4) { const int hq = w; const float sink = p.in[13][kvh * 4 + hq];
        const float v0 = sc[hq * 132 + lane], v1 = sc[hq * 132 + 64 + lane], v2 = lane == 0 ? sc[hq * 132 + 128] : -INFINITY;
        const float mx = fmaxf(wave_max(fmaxf(fmaxf(v0, v1), v2)), sink);
        const float e0 = __expf(v0 - mx), e1 = __expf(v1 - mx), e2 = lane == 0 ? __expf(v2 - mx) : 0.f;
        const float inv = 1.0f / (wave_sum(e0 + e1 + e2) + __expf(sink - mx));
        sc[hq * 132 + lane] = e0 * inv; sc[hq * 132 + 64 + lane] = e1 * inv; if (lane == 0) sc[hq * 132 + 128] = e2 * inv; }
    LBAR();
    if (tid < 256) { const int hq = w; float o = 0.f;
#pragma unroll 4
        for (int j = 0; j < 129; ++j) o += sc[hq * 132 + j] * Vf[j * 64 + lane];
        AO[tok * 1024 + (kvh * 4 + hq) * 64 + lane] = (bf16)f2bf(o); }
    LBAR();
}

__device__ __forceinline__ void mem_decode_item(const KP& p, LAS unsigned char* lds, int item) {
    const int tid = threadIdx.x, lane = tid & 63, w = tid >> 6;
    const int h = item & 3, b = item >> 2;
    const size_t tok = (size_t)(MP + b);
    LAS float* sc = LDSP(float, 0); LAS float* part = LDSP(float, 1024);
    const bf16* PA = (const bf16*)(p.ws + WS_BIG);
    bf16* MO = (bf16*)(p.ws + WS_MO);
    float q[4];
    {   const v2u qz = *(const v2u*)(PA + tok * NA + CQM + h * 256 + lane * 4);
        q[0] = lo16(qz.x); q[1] = hi16(qz.x); q[2] = lo16(qz.y); q[3] = hi16(qz.y);
        const float ss = wave_sum((q[0] * q[0] + q[1] * q[1]) + (q[2] * q[2] + q[3] * q[3]));
        const float rs = rsqrtf(ss * (1.0f / 256.0f) + EPS) * 0.0625f;
        const f32x4 wq = *(const f32x4*)(p.in[22] + lane * 4);
        q[0] *= rs * wq[0]; q[1] *= rs * wq[1]; q[2] *= rs * wq[2]; q[3] *= rs * wq[3]; }
    const float* Kb = p.in[4] + ((size_t)(b * 256) * 4 + h) * 256;
    const float* Vb = p.in[5] + ((size_t)(b * 256) * 4 + h) * 256;
#pragma unroll 8
    for (int i = 0; i < 32; ++i) { const int m = w * 32 + i;
        const f32x4 kv = *(const f32x4*)(Kb + (size_t)m * 1024 + lane * 4);
        const float d = wave_sum((q[0] * kv[0] + q[1] * kv[1]) + (q[2] * kv[2] + q[3] * kv[3]));
        if (lane == 0) sc[m] = d; }
    LBAR();
    if (w == 0) { const f32x4 v = *(LAS f32x4*)(sc + lane * 4);
        const float mx = wave_max(fmaxf(fmaxf(v[0], v[1]), fmaxf(v[2], v[3])));
        const float e0 = __expf(v[0] - mx), e1 = __expf(v[1] - mx), e2 = __expf(v[2] - mx), e3 = __expf(v[3] - mx);
        const float inv = 1.0f / wave_sum((e0 + e1) + (e2 + e3));
        *(LAS f32x4*)(sc + lane * 4) = (f32x4){e0 * inv, e1 * inv, e2 * inv, e3 * inv}; }
    LBAR();
    {   f32x4 o = {0.f, 0.f, 0.f, 0.f};
#pragma unroll 8
        for (int i = 0; i < 32; ++i) { const int m = w * 32 + i; o += *(const f32x4*)(Vb + (size_t)m * 1024 + lane * 4) * sc[m]; }
        *(LAS f32x4*)(part + w * 256 + lane * 4) = o; }
    LBAR();
    if (tid < 256) { float o = part[tid];
#pragma unroll
        for (int g8 = 1; g8 < 8; ++g8) o += part[g8 * 256 + tid];
        MO[tok * 1024 + h * 256 + tid] = (bf16)f2bf(o); }
    LBAR();
}

__device__ __forceinline__ void ssd_norm_pass(const KP& p) {
    const int tid = threadIdx.x, lane = tid & 63, wave = tid >> 6;
    const int gw = blockIdx.x * 8 + wave, NGW = gridDim.x * 8;
    const float* SSQ = (const float*)(p.ws + WS_SSQ);
    bf16* SO = (bf16*)((unsigned char*)(p.out + O_YP) + YP_SO);
    for (int r = gw; r < MTOK; r += NGW) {
#pragma unroll
        for (int it = 0; it < 4; ++it) {
            const f32x4 a = *(const f32x4*)(SSQ + (size_t)r * 32 + it * 8), c = *(const f32x4*)(SSQ + (size_t)r * 32 + it * 8 + 4);
            const float rs = rsqrtf(((a[0] + a[1]) + (a[2] + a[3]) + (c[0] + c[1]) + (c[2] + c[3])) * (1.0f / 512.0f) + EPS);
            v4u* ptr = (v4u*)(SO + (size_t)r * 2048 + it * 512 + lane * 8);
            const v4u z = *ptr; float t[8]; UNPACK8(z, t);
            v4u o; o.x = pk2(t[0] * rs, t[1] * rs); o.y = pk2(t[2] * rs, t[3] * rs); o.z = pk2(t[4] * rs, t[5] * rs); o.w = pk2(t[6] * rs, t[7] * rs);
            *ptr = o;
        }
    }
}


#ifndef NO_SSDP
#define ITEM_SSDP { int b_, h_; if (G_ == 256) { const int xcd = bid & 7, slot = bid >> 3, gi = (slot >> 3) * 8 + xcd; b_ = (it >> 8) * 8 + (gi >> 2); h_ = (gi & 3) * 8 + (slot & 7); } else { b_ = it >> 5; h_ = it & 31; } ssd_prompt_item(p, lds, b_, h_); }
#else
#define ITEM_SSDP
#endif
#ifndef NO_MEMP
#define ITEM_MEMP mem_prompt_item(p, lds, it);
#else
#define ITEM_MEMP
#endif
#ifndef NO_SWAP
#define ITEM_SWAP swa_prompt_item(p, lds, it);
#else
#define ITEM_SWAP
#endif
#ifndef NO_SSDD
#define ITEM_SSDD ssd_decode_item(p, lds, it);
#else
#define ITEM_SSDD
#endif
#ifndef NO_MEMD
#define ITEM_MEMD mem_decode_item(p, lds, it);
#else
#define ITEM_MEMD
#endif
#ifndef NO_SWAD
#define ITEM_SWAD swa_decode_item(p, lds, it);
#else
#define ITEM_SWAD
#endif

#ifndef REP_P0
#define REP_P0 1
#endif
#ifndef REP_P2
#define REP_P2 1
#endif
#ifndef REP_SSDP
#define REP_SSDP REP_P2
#endif
#ifndef REP_MEMP
#define REP_MEMP REP_P2
#endif
#ifndef REP_SWAP
#define REP_SWAP REP_P2
#endif
#ifndef REP_SSDD
#define REP_SSDD REP_P2
#endif
#ifndef REP_MEMD
#define REP_MEMD REP_P2
#endif
#ifndef REP_SWAD
#define REP_SWAD REP_P2
#endif
#ifndef REP_P6
#define REP_P6 1
#endif
#define XB_TMO      128
#define XB_XCNT(j)  (256  + 64 * (j))
#define XB_XSUB(j)  (1280 + 64 * (j))
#define XB_XGEN(j)  (2304 + 64 * (j))
#define XB_TOP      3328
#define XB_TOPGEN   3392
#define XCD_BAR_WORDS 3456
#define XB_SPIN_CAP (1u << 18)

__device__ __forceinline__ unsigned xb_ld(unsigned* p)              { return __hip_atomic_load(p, __ATOMIC_RELAXED, __HIP_MEMORY_SCOPE_AGENT); }
__device__ __forceinline__ unsigned xb_add(unsigned* p, unsigned v) { return __hip_atomic_fetch_add(p, v, __ATOMIC_RELAXED, __HIP_MEMORY_SCOPE_AGENT); }
__device__ __forceinline__ unsigned xb_xcc_id() { return (unsigned)__builtin_amdgcn_s_getreg((3 << 11) | 20) & 0xFu; }
#define XB_SPIN(cond, bar) do { unsigned _sp = 0; while (cond) { __builtin_amdgcn_s_sleep(1); \
    if ((++_sp & 255u) == 0u) { if (xb_ld(&(bar)[XB_TMO])) break; if (_sp > XB_SPIN_CAP) { atomicAdd(&(bar)[XB_TMO], 1u); break; } } } } while (0)

struct XcdBarrier {
    unsigned* bar; unsigned x;
    volatile LAS unsigned* st;
};

__device__ __forceinline__ XcdBarrier xcd_barrier_post(unsigned* bar, volatile LAS unsigned* st) {
    XcdBarrier b; b.bar = bar; b.x = xb_xcc_id(); b.st = st;
    if (threadIdx.x == 0) (void)xb_add(&bar[XB_XCNT(b.x)], 1u);
    return b;
}
__device__ __forceinline__ void xcd_barrier_complete(unsigned* bar, unsigned x, unsigned& nloc, unsigned& nx) {
    const unsigned G = gridDim.x * gridDim.y * gridDim.z;
    unsigned sum, cnt, mine, sp = 0u;
    for (;;) {
        sum = 0u; cnt = 0u; mine = 0u;
#pragma unroll
        for (unsigned j = 0; j < 16; ++j) { const unsigned c = xb_ld(&bar[XB_XCNT(j)]); sum += c; cnt += (c > 0u) ? 1u : 0u; mine = (j == x) ? c : mine; }
        if (sum == G) break;
        __builtin_amdgcn_s_sleep(1);
        if ((++sp & 255u) == 0u) { if (xb_ld(&bar[XB_TMO])) break; if (sp > XB_SPIN_CAP) { atomicAdd(&bar[XB_TMO], 1u); break; } }
    }
    nloc = mine > 0u ? mine : 1u; nx = cnt > 0u ? cnt : 1u;
}

__device__ __forceinline__ void xcd_barrier(const XcdBarrier& b) {
    asm volatile("s_waitcnt vmcnt(0)" ::: "memory");
    __syncthreads();
    if (threadIdx.x == 0) {
        unsigned* bar = b.bar;
        __builtin_amdgcn_s_waitcnt(0);
        unsigned nloc = b.st[0], nx = b.st[1];
        if (nloc == 0u) { xcd_barrier_complete(bar, b.x, nloc, nx); b.st[0] = nloc; b.st[1] = nx; }
        const unsigned old = xb_add(&bar[XB_XSUB(b.x)], 1u);
        const unsigned gen = old / nloc;
        if (old + 1u == (gen + 1u) * nloc) {
            __builtin_amdgcn_fence(__ATOMIC_RELEASE, "agent");
            asm volatile("s_waitcnt vmcnt(0)" ::: "memory");
            const unsigned og = xb_add(&bar[XB_TOP], 1u);
            const unsigned tg = og / nx;
            if (og + 1u == (tg + 1u) * nx) xb_add(&bar[XB_TOPGEN], 1u);
            else XB_SPIN(xb_ld(&bar[XB_TOPGEN]) == tg, bar);
            __builtin_amdgcn_fence(__ATOMIC_ACQUIRE, "agent");
            xb_add(&bar[XB_XGEN(b.x)], 1u);
            asm volatile("s_waitcnt vmcnt(0)" ::: "memory");
        } else {
            XB_SPIN(xb_ld(&bar[XB_XGEN(b.x)]) == gen, bar);
            __builtin_amdgcn_fence(__ATOMIC_ACQUIRE, "agent");
            asm volatile("s_waitcnt vmcnt(0)" ::: "memory");
        }
    }
    __syncthreads();
}


#ifndef STAGGER
#define STAGGER 0
#endif
__device__ __forceinline__ void stagger(int us) {
    if (STAGGER && (blockIdx.x & 7) >= 4) { const unsigned long long t0 = __builtin_amdgcn_s_memrealtime(); while (__builtin_amdgcn_s_memrealtime() - t0 < (unsigned long long)us * 100ull) __builtin_amdgcn_s_sleep(16); }
    __syncthreads();
}
#define GEMM(EpiT, Eobj, Aptr, Bptr, M_, N_, K_, cid) do { pg8::Gemm g_{(const pg8::bf16_t*)(Aptr), (const pg8::bf16_t*)(Bptr), M_, N_, K_}; pg8::StaticOrder S_; S_.init(M_, N_, (int)gridDim.x, (cid)); \
    pg8::gemm_phase<EpiT, pg8::StaticOrder, PG8_ALIGN, PG8_SP2>(lds, g_, S_, Eobj); } while (0)


#ifdef PROBE_TA
#define STAMP(k) do { if (blockIdx.x == 0 && threadIdx.x == 0) ((unsigned long long*)(ws + WS_TS))[k] = __builtin_amdgcn_s_memrealtime(); } while (0)
#else
#define STAMP(k) do { } while (0)
#endif
__global__ void __launch_bounds__(512, 2) mega(KP p) {
    extern __shared__ __attribute__((aligned(16))) unsigned char lds_raw[];
    LAS unsigned char* lds = (LAS unsigned char*)lds_raw;
    cg::grid_group grid = cg::this_grid();
    unsigned char* ws = p.ws;
    const int lo = p.ph_lo, hi = p.ph_hi;
#define IN(k) (lo <= (k) && (k) < hi)
#define SEAM(k) do { if (IN(k) && IN((k) + 1)) xcd_barrier(xb); } while (0)
    bf16* XB = (bf16*)(ws + WS_XB); bf16* MG = (bf16*)(ws + WS_XCX);
    bf16* PA = (bf16*)(ws + WS_BIG); bf16* GATES = PA; bf16* GATES_S = (bf16*)(ws + WS_BIG + (size_t)MP * NG * 2); bf16* ACT = (bf16*)(ws + WS_BIG + BIG_ACT); bf16* X1B = (bf16*)(ws + WS_BIG + BIG_X1B);
    bf16* AO = (bf16*)((unsigned char*)(p.out + O_YP) + YP_AO); bf16* SO = (bf16*)((unsigned char*)(p.out + O_YP) + YP_SO); bf16* MO = (bf16*)(ws + WS_MO);
    float* RS1 = (float*)(ws + WS_RS1); float* RSM = (float*)(ws + WS_RSM); float* PART = (float*)(ws + WS_PART);
    const int bid = (int)blockIdx.x;
    STAMP(0);
    volatile LAS unsigned* xst = (volatile LAS unsigned*)(lds + LDS_BYTES - 16);
    if (threadIdx.x < 2) xst[threadIdx.x] = 0u;
    if (bid == 0) for (int i = threadIdx.x; i < XCD_BAR_WORDS; i += 512) ((unsigned*)(ws + WS_BAR))[i] = 0u;
    __syncthreads();

    if (IN(0))
_Pragma("nounroll")
    for (int rep_ = 0; rep_ < REP_P0; ++rep_) { prologue(p, lds); __syncthreads(); }
    if (IN(0) && IN(1)) grid.sync();
    XcdBarrier xb = xcd_barrier_post((unsigned*)(ws + WS_BAR), xst);
    STAMP(1);
    if (IN(1)) {
        stagger(24);
        EpiProj<0> E1{PA, NA, RS1, (float*)(ws + WS_DT), CDT, 32, 32, 0};
        GEMM(EpiProj<0>, E1, XB, ws + WS_WIN, MP, NA, 2048, bid);
        EpiProj<0> E2{(bf16*)(ws + WS_MKV), 2048, RSM, p.out + O_PMV, 1024, 1024, 1024, 0};
        GEMM(EpiProj<0>, E2, ws + WS_MB, ws + WS_WM, 4096, 2048, 2048, (int)gridDim.x - 1 - bid);
        skinny_proj<0>(lds, XB + (size_t)MP * 2048, (const bf16*)(ws + WS_WIN), NA, 2048, PA, NA, RS1, (float*)(ws + WS_DT), CDT, 32, 32);
    }
    SEAM(1); STAMP(2);
    if (IN(2)) {
        const int G_ = (int)gridDim.x;
        conv_prepass(p);
        memk_norm_pass(p);
        for (int rep_ = 0; rep_ < REP_SWAP; ++rep_) swa_prompt_all(p, lds, bid, G_, 1024);
        for (int it_ = bid; it_ < 4096 * REP_SSDD; it_ += G_) { const int it = it_ & 4095; ITEM_SSDD }
        for (int it_ = bid; it_ < 512 * REP_MEMD; it_ += G_) { const int it = it_ & 511; ITEM_MEMD }
        for (int it_ = bid; it_ < 512 * REP_SWAD; it_ += G_) { const int it = it_ & 511; ITEM_SWAD }
        xcd_barrier(xb);
        STAMP(3);
        for (int it_ = bid; it_ < 512 * REP_SSDP; it_ += G_) { const int it = it_ & 511; ITEM_SSDP }
        for (int it_ = bid; it_ < 1024 * REP_MEMP; it_ += G_) { const int it = it_ & 1023; ITEM_MEMP }
    }
    SEAM(2); STAMP(4);
    if (IN(3)) {
        ssd_norm_pass(p);
        late_weights(p, lds);
        stagger(24);
        EpiProj<1> E{GATES, NG, RS1, nullptr, 0, 0, 0, 128};
        GEMM(EpiProj<1>, E, XB, ws + WS_WIN + (size_t)NA * 2048 * 2, MP, NG, 2048, bid);
        skinny_proj<1>(lds, XB + (size_t)MP * 2048, (const bf16*)(ws + WS_WIN + (size_t)NA * 2048 * 2), NG, 2048, GATES_S - (size_t)MP * NG, NG, RS1, nullptr, 0, 0, 0);
    }
    SEAM(3); STAMP(5);
    if (IN(4)) {
        stagger(15);
        EpiMerge<0> Ea{MG, GATES};
        GEMM(EpiMerge<0>, Ea, AO, ws + WS_WSWA, MP, 2048, 1024, bid);
        EpiMerge<1> Eb{MG, GATES + ((size_t)(16 * 128) << 16)};
        GEMM(EpiMerge<1>, Eb, MO, ws + WS_WMEM, MP, 2048, 1024, bid);
        EpiMerge<1> Ec{MG, GATES + ((size_t)(8 * 128) << 16)};
        GEMM(EpiMerge<1>, Ec, SO, ws + WS_WSSD, MP, 2048, 2048, bid);
        skinny_merge<0>(lds, AO + (size_t)MP * 1024, (const bf16*)(ws + WS_WSWA), 1024, MG, GATES_S - (size_t)MP * NG);
        skinny_merge<1>(lds, MO + (size_t)MP * 1024, (const bf16*)(ws + WS_WMEM), 1024, MG, GATES_S - (size_t)MP * NG + 4096);
        skinny_merge<1>(lds, SO + (size_t)MP * 2048, (const bf16*)(ws + WS_WSSD), 2048, MG, GATES_S - (size_t)MP * NG + 2048);
    }
    SEAM(4); STAMP(6);
    if (IN(5)) {
        stagger(28);
        EpiWout E{XB, X1B, PART};
        GEMM(EpiWout, E, MG, ws + WS_WOUT, MP, 2048, 2048, bid);
        skinny_wout(lds, MG + (size_t)MP * 2048, (const bf16*)(ws + WS_WOUT), p.in[1], X1B, (float*)(ws + WS_PARTS));
    }
    SEAM(5); STAMP(7);
    if (IN(6))
_Pragma("nounroll")
    for (int rep_ = 0; rep_ < REP_P6; ++rep_) {
        stagger(28);
        EpiFfnUp E{PART, ACT};
        GEMM(EpiFfnUp, E, X1B, ws + WS_WGU, MP, 2 * DFF, 2048, bid);
        skinny_ffn_up(lds, X1B + (size_t)MP * 2048, (const bf16*)(ws + WS_WGU), (const float*)(ws + WS_PARTS), ACT);
    }
    SEAM(6); STAMP(8);
    if (IN(7)) {
        EpiDown E{p.out + O_YP, p.out + O_YS, X1B};
        GEMM(EpiDown, E, ACT, ws + WS_WD, MP, 2048, DFF, bid);
        skinny_down(lds, ACT + (size_t)MP * DFF, (const bf16*)(ws + WS_WD), p.out + O_YS, X1B);
    }
#ifdef PROBE_TA
    if (blockIdx.x == 0) { __syncthreads(); if (threadIdx.x == 0) {
        unsigned long long* TS = (unsigned long long*)(ws + WS_TS); TS[9] = __builtin_amdgcn_s_memrealtime();
#ifdef PROBE_TB
        const unsigned long long ta = TS[PROBE_TA + 1] - TS[PROBE_TA], tb = TS[PROBE_TB + 1] - TS[PROBE_TB];
        unsigned long long qa = (ta + 1000) / 2000, qb = (tb + 1000) / 2000; if (qa > 99) qa = 99; if (qb > 99) qb = 99;
        const unsigned long long wait = 2000ull * (qa + 100ull * qb), t0 = __builtin_amdgcn_s_memrealtime();
#else
        const unsigned long long wait = TS[PROBE_TA + 1] - TS[PROBE_TA], t0 = __builtin_amdgcn_s_memrealtime();
#endif
        while (__builtin_amdgcn_s_memrealtime() - t0 < wait) __builtin_amdgcn_s_sleep(32);
    } }
#endif
#undef IN
#undef SEAM
}

#ifndef N_LAUNCHES
#define N_LAUNCHES 1
#endif
extern "C" void kernel_launch(void* const* d_in, const int* in_sizes, int n_in, void* d_out, int out_size, void* d_ws, size_t ws_size, hipStream_t stream) {
    static int grid = 0;
    if (grid == 0) {
        if (n_in != 32 || (size_t)out_size != O_END || ws_size < WS_END) { fprintf(stderr, "kernel_launch: unexpected sizes n_in %d out %d ws %zu (need %zu)\n", n_in, out_size, ws_size, (size_t)WS_END); grid = -1; return; }
        int dev = 0, cus = 0, per_cu = 0;
        hipGetDevice(&dev); hipDeviceGetAttribute(&cus, hipDeviceAttributeMultiprocessorCount, dev);
        if (hipFuncSetAttribute((const void*)mega, hipFuncAttributeMaxDynamicSharedMemorySize, LDS_BYTES) != hipSuccess) { fprintf(stderr, "kernel_launch: hipFuncSetAttribute failed\n"); grid = -1; return; }
        if (hipOccupancyMaxActiveBlocksPerMultiprocessor(&per_cu, (const void*)mega, 512, LDS_BYTES) != hipSuccess || per_cu < 1) { fprintf(stderr, "kernel_launch: occupancy query says %d\n", per_cu); per_cu = 1; }
        (void)hipGetLastError();
        grid = cus;
    }
    if (grid < 0) return;
    KP p{};
    for (int i = 0; i < 32; ++i) p.in[i] = (const float*)d_in[i];
    p.out = (float*)d_out; p.ws = (unsigned char*)d_ws;
#if N_LAUNCHES == 1
    p.ph_lo = 0; p.ph_hi = 8;
    void* args[] = {&p};
    hipError_t e = hipLaunchCooperativeKernel((const void*)mega, dim3(grid), dim3(512), args, LDS_BYTES, stream);
    if (e != hipSuccess) fprintf(stderr, "cooperative launch failed: %s (grid %d)\n", hipGetErrorString(e), grid);
#else
    for (int k = 0; k < 8; ++k) { p.ph_lo = k; p.ph_hi = k + 1; hipLaunchKernelGGL(mega, dim3(grid), dim3(512), LDS_BYTES, stream, p); }
#endif
}
```
